# Optimizing an MI355X kernel written in HIP

```python
import math
import jax, jax.numpy as jnp
from jax import lax
import numpy as np

D_MODEL = 1024
BATCH = 4
SEQ = 4096
DEPTH = 2

D_MIX = D_MODEL
D_HALF = D_MIX // 2
S5_GROUP = 16
S5_GROUPS = D_HALF // S5_GROUP
S5_STATE = 64
S5_DT_MIN = 0.001
S5_DT_MAX = 0.1
SGU_CHUNK = 128
SGU_HEADS = 4
SGU_HEAD_DIM = D_HALF // SGU_HEADS
POOL_WINDOWS = (2, 4, 8, 16)
POOL_GROUP_DIM = D_HALF // len(POOL_WINDOWS)
HGRN_HEAD_DIM = 128
HGRN_HEADS = D_HALF // HGRN_HEAD_DIM
HGRN_CHUNK = 64
D_FF = 2816
N_EVEN = (DEPTH + 1) // 2
N_ODD = DEPTH // 2
EVEN_IN = 3 * D_HALF
ODD_IN = 5 * D_HALF
EPS = 1e-6

kernel_name = 'hybrid_s5_sgu_pool_hgrn2_macaron'

F32 = jnp.float32


def rmsnorm(x, g):
    xf = x.astype(F32)
    y = xf * lax.rsqrt(jnp.mean(xf * xf, axis=-1, keepdims=True) + EPS)
    return (y * g.astype(F32)).astype(x.dtype)


def swiglu(h, wg, wu, wd):
    return (jax.nn.silu(h @ wg) * (h @ wu)) @ wd


def _complex_affine_combine(earlier, later):
    a1r, a1i, b1r, b1i = earlier
    a2r, a2i, b2r, b2i = later
    return (a2r * a1r - a2i * a1i,
            a2r * a1i + a2i * a1r,
            a2r * b1r - a2i * b1i + b2r,
            a2r * b1i + a2i * b1r + b2i)


def s5_mixer(u, lam_re, lam_im, log_dt, b_re, b_im, c_re, c_im, d_skip, w_glu):
    bsz, seq, _ = u.shape
    uf = u.astype(F32).reshape(bsz, seq, S5_GROUPS, S5_GROUP)
    lr = lam_re.astype(F32)
    li = lam_im.astype(F32)
    dt = jnp.exp(log_dt.astype(F32))[:, None]
    mag = jnp.exp(lr * dt)
    a_re = mag * jnp.cos(li * dt)
    a_im = mag * jnp.sin(li * dt)
    den = lr * lr + li * li
    coef_re = ((a_re - 1.0) * lr + a_im * li) / den
    coef_im = (a_im * lr - (a_re - 1.0) * li) / den
    br = b_re.astype(F32)
    bi = b_im.astype(F32)
    bbar_re = coef_re[..., None] * br - coef_im[..., None] * bi
    bbar_im = coef_re[..., None] * bi + coef_im[..., None] * br
    bu_re = jnp.einsum('blgc,gpc->blgp', uf, bbar_re)
    bu_im = jnp.einsum('blgc,gpc->blgp', uf, bbar_im)
    a_re_b = jnp.broadcast_to(a_re, bu_re.shape)
    a_im_b = jnp.broadcast_to(a_im, bu_im.shape)
    _, _, x_re, x_im = lax.associative_scan(
        _complex_affine_combine, (a_re_b, a_im_b, bu_re, bu_im), axis=1)
    y = (jnp.einsum('blgp,gcp->blgc', x_re, c_re.astype(F32))
         - jnp.einsum('blgp,gcp->blgc', x_im, c_im.astype(F32)))
    y = y.reshape(bsz, seq, D_HALF) + d_skip.astype(F32) * uf.reshape(bsz, seq, D_HALF)
    y = jax.nn.gelu(y)
    y = y * jax.nn.sigmoid(y @ w_glu.astype(F32))
    return y.astype(u.dtype)


def sgu_mixer(zu, zv, norm_g, w_s, b_s):
    bsz, seq, _ = zu.shape
    u = jax.nn.gelu(zu.astype(F32))
    v = jax.nn.gelu(zv.astype(F32))
    mu = jnp.mean(v, axis=-1, keepdims=True)
    var = jnp.mean(jnp.square(v - mu), axis=-1, keepdims=True)
    vn = (v - mu) * lax.rsqrt(var + EPS) * norm_g.astype(F32)
    nch = seq // SGU_CHUNK
    vc = vn.reshape(bsz, nch, SGU_CHUNK, SGU_HEADS, SGU_HEAD_DIM)
    mask = jnp.tril(jnp.ones((SGU_CHUNK, SGU_CHUNK), dtype=bool))
    w = jnp.where(mask, w_s.astype(F32), 0.0)
    s = jnp.einsum('hts,bnshc->bnthc', w, vc) + b_s.astype(F32).T[None, None, :, :, None]
    return (u * s.reshape(bsz, seq, D_HALF)).astype(zu.dtype)


def pool_mixer(z, w_pool, scale):
    bsz, seq, _ = z.shape
    zf = z.astype(F32)
    csum = jnp.pad(jnp.cumsum(zf, axis=1), ((0, 0), (1, 0), (0, 0)))
    pos = jnp.arange(1, seq + 1, dtype=F32)
    outs = []
    for gi, win in enumerate(POOL_WINDOWS):
        sl = slice(gi * POOL_GROUP_DIM, (gi + 1) * POOL_GROUP_DIM)
        cg = csum[:, :, sl]
        lagged = jnp.pad(cg, ((0, 0), (win, 0), (0, 0)))[:, :seq + 1]
        wsum = (cg - lagged)[:, 1:]
        mean = wsum / jnp.minimum(pos, float(win))[None, :, None]
        outs.append((mean - zf[:, :, sl]) @ w_pool[gi].astype(F32))
    y = jnp.concatenate(outs, axis=-1) * scale.astype(F32)
    return y.astype(z.dtype)


def hgrn2_mixer(zq, zf, zi, zg, lb, onorm_g):
    bsz, seq, _ = zq.shape
    lbf = lb.astype(F32)
    q = jax.nn.silu(zq.astype(F32))
    fgate = lbf + (1.0 - lbf) * jax.nn.sigmoid(zf.astype(F32))
    logf = jnp.log(fgate)
    k = 1.0 - fgate
    v = zi.astype(F32)
    nch = seq // HGRN_CHUNK

    def to_chunks(t):
        return t.reshape(bsz, nch, HGRN_CHUNK, HGRN_HEADS, HGRN_HEAD_DIM).transpose(1, 0, 3, 2, 4)

    mask = jnp.tril(jnp.ones((HGRN_CHUNK, HGRN_CHUNK), dtype=bool))

    def step(state, inp):
        qc, kc, vc, lc = inp
        b = jnp.cumsum(lc, axis=2)
        diff = b[:, :, :, None, :] - b[:, :, None, :, :]
        decay = jnp.exp(jnp.where(mask[:, :, None], diff, -jnp.inf))
        scores = jnp.einsum('bhtk,bhtsk,bhsk->bhts', qc, decay, kc)
        o = (jnp.einsum('bhts,bhsv->bhtv', scores, vc)
             + jnp.einsum('bhtk,bhkv->bhtv', qc * jnp.exp(b), state))
        b_last = b[:, :, -1:, :]
        new_state = (jnp.exp(b_last[:, :, 0, :])[..., None] * state
                     + jnp.einsum('bhsk,bhsv->bhkv', kc * jnp.exp(b_last - b), vc))
        return new_state, o

    s0 = jnp.zeros((bsz, HGRN_HEADS, HGRN_HEAD_DIM, HGRN_HEAD_DIM), F32)
    _, o = lax.scan(step, s0, (to_chunks(q), to_chunks(k), to_chunks(v), to_chunks(logf)))
    o = o.transpose(1, 0, 3, 2, 4).reshape(bsz, seq, HGRN_HEADS, HGRN_HEAD_DIM)
    o = o * lax.rsqrt(jnp.mean(o * o, axis=-1, keepdims=True) + EPS) * onorm_g.astype(F32)
    g = jax.nn.silu(zg.astype(F32)).reshape(bsz, seq, HGRN_HEADS, HGRN_HEAD_DIM)
    return (o * g).reshape(bsz, seq, D_HALF).astype(zq.dtype)


def setup_inputs(seed: int = 0) -> dict:
    key = jax.random.key(seed)
    ks = jax.random.split(key, 32)

    def nrm(k, shape, scale=1.0):
        return jax.random.normal(k, shape, F32) * scale

    x = nrm(ks[0], (BATCH, SEQ, D_MODEL))
    norm_g = 1.0 + nrm(ks[1], (DEPTH, 6, D_MODEL), 0.02)
    ffn_wg = nrm(ks[2], (DEPTH, 2, D_MODEL, D_FF), D_MODEL ** -0.5)
    ffn_wu = nrm(ks[3], (DEPTH, 2, D_MODEL, D_FF), D_MODEL ** -0.5)
    ffn_wd = nrm(ks[4], (DEPTH, 2, D_FF, D_MODEL), D_FF ** -0.5)
    even_w_in = nrm(ks[5], (N_EVEN, D_MODEL, EVEN_IN), D_MODEL ** -0.5)
    even_w_out = nrm(ks[6], (N_EVEN, D_MIX, D_MODEL), D_MIX ** -0.5)
    s5_lam_re = -0.5 + nrm(ks[7], (N_EVEN, S5_GROUPS, S5_STATE), 0.01)
    s5_lam_im = (math.pi * jnp.arange(S5_STATE, dtype=F32))[None, None, :] + nrm(ks[8], (N_EVEN, S5_GROUPS, S5_STATE), 0.01)
    s5_log_dt = jax.random.uniform(ks[9], (N_EVEN, S5_GROUPS), F32, minval=math.log(S5_DT_MIN), maxval=math.log(S5_DT_MAX))
    s5_b_re = nrm(ks[10], (N_EVEN, S5_GROUPS, S5_STATE, S5_GROUP), (2 * S5_GROUP) ** -0.5)
    s5_b_im = nrm(ks[11], (N_EVEN, S5_GROUPS, S5_STATE, S5_GROUP), (2 * S5_GROUP) ** -0.5)
    s5_c_re = nrm(ks[12], (N_EVEN, S5_GROUPS, S5_GROUP, S5_STATE), S5_STATE ** -0.5)
    s5_c_im = nrm(ks[13], (N_EVEN, S5_GROUPS, S5_GROUP, S5_STATE), S5_STATE ** -0.5)
    s5_d = nrm(ks[14], (N_EVEN, D_HALF))
    s5_w_glu = nrm(ks[15], (N_EVEN, D_HALF, D_HALF), D_HALF ** -0.5)
    sgu_norm_g = 1.0 + nrm(ks[16], (N_EVEN, D_HALF), 0.02)
    sgu_w = nrm(ks[17], (N_EVEN, SGU_HEADS, SGU_CHUNK, SGU_CHUNK), SGU_CHUNK ** -0.5)
    sgu_b = 1.0 + nrm(ks[18], (N_EVEN, SGU_HEADS, SGU_CHUNK), 0.02)
    odd_w_in = nrm(ks[19], (N_ODD, D_MODEL, ODD_IN), D_MODEL ** -0.5)
    odd_w_out = nrm(ks[20], (N_ODD, D_MIX, D_MODEL), D_MIX ** -0.5)
    pool_w = nrm(ks[21], (N_ODD, len(POOL_WINDOWS), POOL_GROUP_DIM, POOL_GROUP_DIM), POOL_GROUP_DIM ** -0.5)
    pool_scale = 1.0 + nrm(ks[22], (N_ODD, D_HALF), 0.1)
    hgrn_lb = nrm(ks[23], (DEPTH, D_HALF))
    hgrn_onorm_g = 1.0 + nrm(ks[24], (N_ODD, HGRN_HEAD_DIM), 0.02)
    return {'x': x, 'norm_g': norm_g, 'ffn_wg': ffn_wg, 'ffn_wu': ffn_wu, 'ffn_wd': ffn_wd,
            'even_w_in': even_w_in, 'even_w_out': even_w_out,
            's5_lam_re': s5_lam_re, 's5_lam_im': s5_lam_im, 's5_log_dt': s5_log_dt,
            's5_b_re': s5_b_re, 's5_b_im': s5_b_im, 's5_c_re': s5_c_re, 's5_c_im': s5_c_im,
            's5_d': s5_d, 's5_w_glu': s5_w_glu,
            'sgu_norm_g': sgu_norm_g, 'sgu_w': sgu_w, 'sgu_b': sgu_b,
            'odd_w_in': odd_w_in, 'odd_w_out': odd_w_out,
            'pool_w': pool_w, 'pool_scale': pool_scale,
            'hgrn_lb': hgrn_lb, 'hgrn_onorm_g': hgrn_onorm_g}


def reference(x, norm_g, ffn_wg, ffn_wu, ffn_wd, even_w_in, even_w_out,
              s5_lam_re, s5_lam_im, s5_log_dt, s5_b_re, s5_b_im, s5_c_re, s5_c_im,
              s5_d, s5_w_glu, sgu_norm_g, sgu_w, sgu_b, odd_w_in, odd_w_out,
              pool_w, pool_scale, hgrn_lb, hgrn_onorm_g):
    sm = jax.nn.softmax(hgrn_lb.astype(F32), axis=0)
    lb_all = jnp.cumsum(sm, axis=0) - sm[0:1]
    for li in range(DEPTH):
        g = norm_g[li]
        j = li // 2
        h = rmsnorm(x, g[0])
        x = x + 0.5 * rmsnorm(swiglu(h, ffn_wg[li, 0], ffn_wu[li, 0], ffn_wd[li, 0]), g[1])
        h = rmsnorm(x, g[2])
        if li % 2 == 0:
            z = h @ even_w_in[j]
            ya = s5_mixer(z[..., :D_HALF], s5_lam_re[j], s5_lam_im[j], s5_log_dt[j],
                          s5_b_re[j], s5_b_im[j], s5_c_re[j], s5_c_im[j], s5_d[j], s5_w_glu[j])
            yb = sgu_mixer(z[..., D_HALF:2 * D_HALF], z[..., 2 * D_HALF:],
                           sgu_norm_g[j], sgu_w[j], sgu_b[j])
            y = jnp.concatenate([ya, yb], axis=-1) @ even_w_out[j]
        else:
            z = h @ odd_w_in[j]
            yc = pool_mixer(z[..., :D_HALF], pool_w[j], pool_scale[j])
            yd = hgrn2_mixer(z[..., D_HALF:2 * D_HALF], z[..., 2 * D_HALF:3 * D_HALF],
                             z[..., 3 * D_HALF:4 * D_HALF], z[..., 4 * D_HALF:],
                             lb_all[li], hgrn_onorm_g[j])
            y = jnp.concatenate([yc, yd], axis=-1) @ odd_w_out[j]
        x = x + rmsnorm(y, g[3])
        h = rmsnorm(x, g[4])
        x = x + 0.5 * rmsnorm(swiglu(h, ffn_wg[li, 1], ffn_wu[li, 1], ffn_wd[li, 1]), g[5])
    return x
```

```cpp
#include <hip/hip_runtime.h>
#include <hip/hip_cooperative_groups.h>
#include <cstdio>
#include <cstdint>
namespace cg = cooperative_groups;
namespace pg8 {
#define PG8_LAS __attribute__((address_space(3)))
typedef unsigned short bf16_t;
typedef short bf16x8 __attribute__((ext_vector_type(8)));
typedef float f32x4 __attribute__((ext_vector_type(4)));
typedef unsigned u32x4 __attribute__((ext_vector_type(4)));
constexpr int BM = 256, BK = 64, HALF = 128, HTB = HALF * BK * 2  , STAGE_BYTES = 8 * HTB, NXCD = 8, WGM = 8;

__host__ __device__ __forceinline__ int lds_byte(int r, int c) { const int st = (r >> 4) * 2 + (c >> 5), rr = r & 15, cc = c & 31, ob = rr * 64 + cc * 2; return st * 1024 + (ob ^ (((ob >> 9) & 1) << 5)); }
__host__ __device__ __forceinline__ void stage_rc(int b, int& R, int& C) { const int st = b / 1024, sb = b % 1024, swz = sb ^ (((sb >> 9) & 1) << 5); R = (st >> 1) * 16 + swz / 64; C = (st & 1) * 32 + (swz % 64) / 2; }
__host__ __device__ __forceinline__ int perm32(int rho) { const int n = rho >> 4, i = rho & 15; return 8 * (i >> 2) + 4 * n + (i & 3); }

struct Unit { int pm, pn; };
struct Gemm { const bf16_t* A; const bf16_t* Bt; int M, N, K; };

struct StaticOrder {
    int nM, nN, nwg, G, c;
    __host__ __device__ void init(int M, int N, int G_, int c_) { nM = M / BM; nN = N / BM; nwg = nM * nN; G = G_; c = c_; }
    __host__ __device__ bool next(int i, Unit& u) const {
        const long L = (long)i * G + c; if (L >= nwg) return false;
        int wgid = (int)L; { const int q = nwg / NXCD, r = nwg % NXCD, xcd = wgid % NXCD, off = wgid / NXCD; wgid = (xcd < r ? xcd * (q + 1) : r * (q + 1) + (xcd - r) * q) + off; }
        const int nig = WGM * nN, gid = wgid / nig, fm = gid * WGM, gsz = (nM - fm) < WGM ? (nM - fm) : WGM;
        u.pm = fm + ((wgid % nig) % gsz); u.pn = (wgid % nig) / gsz; return true;
    }
    __device__ __forceinline__ void a_ready(const Unit&) const {}
    __device__ __forceinline__ void done(const Unit&) const {}
};

__device__ __forceinline__ unsigned cvt_pk_bf16(float lo, float hi) { unsigned r; asm volatile("v_cvt_pk_bf16_f32 %0, %1, %2" : "=v"(r) : "v"(lo), "v"(hi)); return r; }
typedef float f32x2 __attribute__((ext_vector_type(2)));
template <class Epi, class Sched, bool ALIGN_EPI = false, bool SP2 = false>
__device__ __forceinline__ void gemm_phase(PG8_LAS unsigned char* lds, const Gemm g, const Sched& S, const Epi& E, const int tid_in) {
    const int tid = tid_in, wid = __builtin_amdgcn_readfirstlane(tid >> 6), lane = tid & 63, wr = wid >> 2, wc = wid & 3, fr = lane & 15, fq = lane >> 4;
    const int K = g.K, nt = K / BK;
    unsigned voffA[2], voffB[2];
#pragma unroll
    for (int i = 0; i < 2; ++i) { int R, C; stage_rc(tid * 16 + i * 8192, R, C); const int Rb = Epi::PERM ? ((R & ~31) + perm32(R & 31)) : R;
        voffA[i] = (unsigned)(R * K + C) * 2u; voffB[i] = (unsigned)(Rb * K + C) * 2u; }
    const size_t kstep = (size_t)(BK * 2);
    const size_t hstep = (size_t)HALF * K * 2;
    const size_t tstep = 2 * hstep;
    const unsigned ldsw = (unsigned)wid * 1024u;
    const int aoff = lds_byte(wr * 64 + fr, fq * 8), boff = lds_byte(wc * 32 + fr, fq * 8);
#define PG8_SA(b, h) (((b) * 2 + (h)) * HTB)
#define PG8_SB(b, h) ((4 + (b) * 2 + (h)) * HTB)
#define PG8_STAGE(bufoff, gbase, voff) do { _Pragma("unroll") for (int _i = 0; _i < 2; ++_i) \
        __builtin_amdgcn_global_load_lds((const unsigned*)((const char*)(gbase) + (voff)[_i]), (PG8_LAS unsigned*)(lds + (bufoff) + ldsw + _i * 8192), 16, 0, 0); } while (0)
#define PG8_LDA(dst, b, h) do { _Pragma("unroll") for (int m = 0; m < 4; ++m) _Pragma("unroll") for (int k = 0; k < 2; ++k) dst[m][k] = *(const PG8_LAS bf16x8*)(lds + PG8_SA(b, h) + aoff + m * 2048 + k * 1024); } while (0)
#define PG8_LDB(dst, b, h) do { _Pragma("unroll") for (int n = 0; n < 2; ++n) _Pragma("unroll") for (int k = 0; k < 2; ++k) dst[n][k] = *(const PG8_LAS bf16x8*)(lds + PG8_SB(b, h) + boff + n * 2048 + k * 1024); } while (0)
#define PG8_MMA(ai, bj, At, Bt) do { __builtin_amdgcn_s_setprio(1); _Pragma("unroll") for (int m = 0; m < 4; ++m) _Pragma("unroll") for (int n = 0; n < 2; ++n) _Pragma("unroll") for (int k = 0; k < 2; ++k) \
        acc[ai][bj][m][n] = __builtin_amdgcn_mfma_f32_16x16x32_bf16(Bt[n][k], At[m][k], acc[ai][bj][m][n], 0, 0, 0); __builtin_amdgcn_s_setprio(0); } while (0)
#define PG8_WAIT_V(n) asm volatile("s_waitcnt vmcnt(" #n ")" ::: "memory")
#define PG8_WAIT_L(n) asm volatile("s_waitcnt lgkmcnt(" #n ")" ::: "memory")
#define PG8_BAR __builtin_amdgcn_s_barrier()
#define PG8_SCHED __builtin_amdgcn_sched_barrier(0)
    Unit cur, nxt; int ui = 0;
    if (!S.next(0, cur)) return;
    f32x4 acc[2][2][4][2];
#pragma unroll
    for (int a = 0; a < 2; ++a)
#pragma unroll
        for (int b = 0; b < 2; ++b)
#pragma unroll
            for (int m = 0; m < 4; ++m)
#pragma unroll
                for (int n = 0; n < 2; ++n) acc[a][b][m][n] = (f32x4){0.f, 0.f, 0.f, 0.f};
    bf16x8 At[4][2], B0[2][2], B1[2][2];
    const char* cA = (const char*)g.A + (size_t)cur.pm * tstep; const char* cB = (const char*)g.Bt + (size_t)cur.pn * tstep;
    S.a_ready(cur);
    if constexpr (SP2) {
        PG8_STAGE(PG8_SB(0, 0), cB, voffB); PG8_STAGE(PG8_SB(0, 1), cB + hstep, voffB); PG8_STAGE(PG8_SA(0, 0), cA, voffA); PG8_STAGE(PG8_SA(0, 1), cA + hstep, voffA);
        if (wr == 1) PG8_BAR;
        PG8_WAIT_V(2); PG8_BAR;
        PG8_STAGE(PG8_SB(1, 0), cB + kstep, voffB); PG8_STAGE(PG8_SA(1, 0), cA + kstep, voffA); PG8_STAGE(PG8_SB(1, 1), cB + hstep + kstep, voffB);
        PG8_WAIT_V(6); PG8_BAR;
    } else {
        PG8_STAGE(PG8_SB(0, 0), cB, voffB); PG8_STAGE(PG8_SA(0, 0), cA, voffA); PG8_STAGE(PG8_SB(0, 1), cB + hstep, voffB); PG8_STAGE(PG8_SA(0, 1), cA + hstep, voffA);
        if (wr == 1) PG8_BAR;
        PG8_WAIT_V(4); PG8_BAR;
        PG8_STAGE(PG8_SB(1, 0), cB + kstep, voffB); PG8_STAGE(PG8_SA(1, 0), cA + kstep, voffA); PG8_STAGE(PG8_SB(1, 1), cB + hstep + kstep, voffB);
        PG8_WAIT_V(6); PG8_BAR;
    }
    for (;;) {
        const bool has_next = S.next(ui + 1, nxt);
        const char* nA = has_next ? (const char*)g.A + (size_t)nxt.pm * tstep : cA; const char* nB = has_next ? (const char*)g.Bt + (size_t)nxt.pn * tstep : cB;
        for (int t = 0; t < nt; t += 2) {
            const bool last = (t == nt - 2);
            const char* a1 = cA + (size_t)(t + 1) * kstep;
            const char* a2 = last ? nA : cA + (size_t)(t + 2) * kstep; const char* b2 = last ? nB : cB + (size_t)(t + 2) * kstep;
            const char* a3 = a2 + kstep; const char* b3 = b2 + kstep;
            if (last && has_next) S.a_ready(nxt);
            if constexpr (SP2) {
            PG8_LDB(B0, 0, 0); PG8_LDB(B1, 0, 1); PG8_SCHED; PG8_LDA(At, 0, 0); PG8_STAGE(PG8_SA(1, 1), a1 + hstep, voffA);
            PG8_WAIT_V(8); PG8_WAIT_L(0); PG8_BAR; PG8_MMA(0, 0, At, B0); PG8_MMA(0, 1, At, B1); PG8_BAR; PG8_SCHED;
            PG8_LDA(At, 0, 1); PG8_STAGE(PG8_SB(0, 0), b2, voffB); PG8_STAGE(PG8_SB(0, 1), b2 + hstep, voffB); PG8_STAGE(PG8_SA(0, 0), a2, voffA);
            PG8_WAIT_V(8); PG8_WAIT_L(0); PG8_BAR; PG8_MMA(1, 0, At, B0); PG8_MMA(1, 1, At, B1); PG8_BAR; PG8_SCHED;
            PG8_LDB(B0, 1, 0); PG8_LDB(B1, 1, 1); PG8_SCHED; PG8_LDA(At, 1, 0); PG8_STAGE(PG8_SA(0, 1), a2 + hstep, voffA);
            PG8_WAIT_V(8); PG8_WAIT_L(0); PG8_BAR; PG8_MMA(0, 0, At, B0); PG8_MMA(0, 1, At, B1); PG8_BAR; PG8_SCHED;
            PG8_LDA(At, 1, 1); PG8_STAGE(PG8_SB(1, 0), b3, voffB); PG8_STAGE(PG8_SB(1, 1), b3 + hstep, voffB); PG8_STAGE(PG8_SA(1, 0), a3, voffA);
            PG8_WAIT_V(8); PG8_WAIT_L(0); PG8_BAR; PG8_MMA(1, 0, At, B0); PG8_MMA(1, 1, At, B1); PG8_BAR; PG8_SCHED;
            } else {
            PG8_LDB(B0, 0, 0); PG8_SCHED; PG8_LDA(At, 0, 0); PG8_STAGE(PG8_SA(1, 1), a1 + hstep, voffA);
            PG8_WAIT_L(8); PG8_BAR; PG8_WAIT_L(0); PG8_MMA(0, 0, At, B0); PG8_BAR; PG8_SCHED;
            PG8_LDB(B1, 0, 1); PG8_STAGE(PG8_SB(0, 0), b2, voffB);
            PG8_BAR; PG8_WAIT_L(0); PG8_MMA(0, 1, At, B1); PG8_BAR;
            PG8_LDA(At, 0, 1); PG8_STAGE(PG8_SA(0, 0), a2, voffA);
            PG8_BAR; PG8_WAIT_L(0); PG8_MMA(1, 0, At, B0); PG8_BAR; PG8_SCHED;
            PG8_STAGE(PG8_SB(0, 1), b2 + hstep, voffB);
            PG8_WAIT_V(6); PG8_BAR; PG8_MMA(1, 1, At, B1); PG8_BAR;
            PG8_LDB(B0, 1, 0); PG8_SCHED; PG8_LDA(At, 1, 0); PG8_STAGE(PG8_SA(0, 1), a2 + hstep, voffA);
            PG8_WAIT_L(8); PG8_BAR; PG8_WAIT_L(0); PG8_MMA(0, 0, At, B0); PG8_BAR; PG8_SCHED;
            PG8_LDB(B1, 1, 1); PG8_STAGE(PG8_SB(1, 0), b3, voffB);
            PG8_BAR; PG8_WAIT_L(0); PG8_MMA(0, 1, At, B1); PG8_BAR;
            PG8_LDA(At, 1, 1); PG8_STAGE(PG8_SA(1, 0), a3, voffA);
            PG8_BAR; PG8_WAIT_L(0); PG8_MMA(1, 0, At, B0); PG8_BAR; PG8_SCHED;
            PG8_STAGE(PG8_SB(1, 1), b3 + hstep, voffB);
            PG8_WAIT_V(6); PG8_BAR; PG8_MMA(1, 1, At, B1); PG8_BAR;
            }
        }
        if constexpr (ALIGN_EPI) { if (wr == 0) PG8_BAR; }
        if constexpr (!Epi::AFTER_DRAIN) { E(acc, cur, wr, wc, fr, fq); S.done(cur); }
        if (!has_next) break;
#pragma unroll
        for (int a = 0; a < 2; ++a)
#pragma unroll
            for (int b = 0; b < 2; ++b)
#pragma unroll
                for (int m = 0; m < 4; ++m)
#pragma unroll
                    for (int n = 0; n < 2; ++n) acc[a][b][m][n] = (f32x4){0.f, 0.f, 0.f, 0.f};
        cur = nxt; cA = nA; cB = nB; ++ui;
        if constexpr (ALIGN_EPI) { if (wr == 1) PG8_BAR; }
    }
    PG8_WAIT_V(0);
    if constexpr (!ALIGN_EPI) { if (wr == 0) PG8_BAR; }
    PG8_BAR;
    if constexpr (Epi::AFTER_DRAIN) { E.fused(acc, cur, wr, wc, fr, fq, lds, wid, lane); S.done(cur); }
#undef PG8_SA
#undef PG8_SB
#undef PG8_STAGE
#undef PG8_LDA
#undef PG8_LDB
#undef PG8_MMA
#undef PG8_WAIT_V
#undef PG8_WAIT_L
#undef PG8_BAR
#undef PG8_SCHED
}
}

#ifndef PG8_SP2
#define PG8_SP2 true
#endif
#ifndef PG8_ALIGN
#define PG8_ALIGN true
#endif

#define LAS __attribute__((address_space(3)))
typedef unsigned short bf16_t;
typedef unsigned v4u __attribute__((ext_vector_type(4)));
typedef unsigned v2u __attribute__((ext_vector_type(2)));
typedef float f32x4 __attribute__((ext_vector_type(4)));
typedef short bf16x8 __attribute__((ext_vector_type(8)));

constexpr int M = 16384, D = 1024, SEQ = 4096, DFF = 2816, DH = 512, EVEN_IN = 1536, ODD_IN = 2560;
constexpr float EPS = 1e-6f;
constexpr size_t MiB = 1u << 20;
constexpr size_t WS_ARE = 0, WS_AIM = 8192, WS_BRE = 16384, WS_BIM = 16384 + 131072;
constexpr size_t WS_S5B = 320 * 1024;
constexpr size_t WS_S5C = 448 * 1024;
constexpr size_t WS_STATS = 576 * 1024;
constexpr size_t WS_WGU = 1 * MiB, WS_WD = 12 * MiB;
constexpr size_t WS_WEIN = 18 * MiB, WS_WEOUT = 21 * MiB, WS_WGLU = 23 * MiB, WS_WOIN = 24 * MiB, WS_WOOUT = 29 * MiB;
constexpr size_t WS_WPOOL = 31 * MiB, WS_WSGU = 31 * MiB + 128 * 1024;
constexpr size_t WS_H = 32 * MiB;
constexpr size_t WS_HID = 64 * MiB, WS_YFFN = 152 * MiB;
constexpr size_t WS_Z = 64 * MiB, WS_YAPRE = 112 * MiB, WS_KV = 144 * MiB, WS_CAT = 176 * MiB, WS_YMIX = 64 * MiB, WS_POOLA = 208 * MiB;
constexpr size_t WS_DL = 240 * MiB;
constexpr int LDS_BYTES = 147456;

__device__ __forceinline__ float bf2f(unsigned h) { return __uint_as_float(h << 16); }
__device__ __forceinline__ unsigned f2bf(float f) { unsigned u = __float_as_uint(f); return (u + 0x7fffu + ((u >> 16) & 1u)) >> 16; }
__device__ __forceinline__ unsigned pk2(float lo, float hi) { return f2bf(lo) | (f2bf(hi) << 16); }
__device__ __forceinline__ float gelu_t(float x) { const float u = 0.7978845608f * (x + 0.044715f * x * x * x); return x / (1.f + __expf(-2.f * u)); }
__device__ __forceinline__ float silu_f(float x) { return x / (1.f + __expf(-x)); }
__device__ __forceinline__ float sigm_f(float x) { return 1.f / (1.f + __expf(-x)); }
__device__ __forceinline__ float wave_sum(float v) {
#pragma unroll
    for (int o = 1; o < 64; o <<= 1) v += __shfl_xor(v, o);
    return v;
}
#define LDS_WAIT() asm volatile("s_waitcnt lgkmcnt(0)" ::: "memory")

struct EpiSwiGLU {
    static constexpr bool PERM = true, AFTER_DRAIN = false; bf16_t* O;
    __device__ __forceinline__ void operator()(const pg8::f32x4 (&acc)[2][2][4][2], const pg8::Unit& u, int wr, int wc, int fr, int fq) const {
        const int row0 = u.pm * 256 + wr * 64 + fr, col0 = u.pn * 128 + wc * 32 + 8 * fq;
#pragma unroll
        for (int ai = 0; ai < 2; ++ai)
#pragma unroll
            for (int m = 0; m < 4; ++m) {
                bf16_t* rowp = O + (size_t)(row0 + ai * 128 + m * 16) * DFF + col0;
                const pg8::f32x4 g0 = acc[ai][0][m][0], g1 = acc[ai][0][m][1], u0 = acc[ai][1][m][0], u1 = acc[ai][1][m][1];
                v4u w;
                w.x = pk2(silu_f(g0[0]) * u0[0], silu_f(g0[1]) * u0[1]); w.y = pk2(silu_f(g0[2]) * u0[2], silu_f(g0[3]) * u0[3]);
                w.z = pk2(silu_f(g1[0]) * u1[0], silu_f(g1[1]) * u1[1]); w.w = pk2(silu_f(g1[2]) * u1[2], silu_f(g1[3]) * u1[3]);
                *(v4u*)rowp = w;
            }
    }
};
struct EpiF32 {
    static constexpr bool PERM = false, AFTER_DRAIN = false; float* O; int ldc;
    __device__ __forceinline__ void operator()(const pg8::f32x4 (&acc)[2][2][4][2], const pg8::Unit& u, int wr, int wc, int fr, int fq) const {
        const int row0 = u.pm * 256 + wr * 64 + fr, col0 = u.pn * 256 + wc * 32 + 4 * fq;
#pragma unroll
        for (int ai = 0; ai < 2; ++ai)
#pragma unroll
            for (int m = 0; m < 4; ++m) {
                float* rowp = O + (size_t)(row0 + ai * 128 + m * 16) * ldc + col0;
#pragma unroll
                for (int bj = 0; bj < 2; ++bj)
#pragma unroll
                    for (int n = 0; n < 2; ++n) *(pg8::f32x4*)(rowp + bj * 128 + n * 16) = acc[ai][bj][m][n];
            }
    }
};
struct EpiBf {
    static constexpr bool PERM = true, AFTER_DRAIN = false; bf16_t* O; int ldc;
    __device__ __forceinline__ void operator()(const pg8::f32x4 (&acc)[2][2][4][2], const pg8::Unit& u, int wr, int wc, int fr, int fq) const {
        const int row0 = u.pm * 256 + wr * 64 + fr, col0 = u.pn * 256 + wc * 32 + 8 * fq;
#pragma unroll
        for (int ai = 0; ai < 2; ++ai)
#pragma unroll
            for (int m = 0; m < 4; ++m) {
                bf16_t* rowp = O + (size_t)(row0 + ai * 128 + m * 16) * ldc + col0;
#pragma unroll
                for (int bj = 0; bj < 2; ++bj) {
                    const pg8::f32x4 v0 = acc[ai][bj][m][0], v1 = acc[ai][bj][m][1];
                    v4u w; w.x = pk2(v0[0], v0[1]); w.y = pk2(v0[2], v0[3]); w.z = pk2(v1[0], v1[1]); w.w = pk2(v1[2], v1[3]);
                    *(v4u*)(rowp + bj * 128) = w;
                }
            }
    }
};
struct EpiGLU {
    static constexpr bool PERM = true, AFTER_DRAIN = false; const bf16_t* Y; bf16_t* O;
    __device__ __forceinline__ void operator()(const pg8::f32x4 (&acc)[2][2][4][2], const pg8::Unit& u, int wr, int wc, int fr, int fq) const {
        const int row0 = u.pm * 256 + wr * 64 + fr, col0 = u.pn * 256 + wc * 32 + 8 * fq;
#pragma unroll
        for (int ai = 0; ai < 2; ++ai)
#pragma unroll
            for (int m = 0; m < 4; ++m) {
                const size_t r = (size_t)(row0 + ai * 128 + m * 16);
#pragma unroll
                for (int bj = 0; bj < 2; ++bj) {
                    const v4u y = *(const v4u*)(Y + r * DH + col0 + bj * 128);
                    const pg8::f32x4 v0 = acc[ai][bj][m][0], v1 = acc[ai][bj][m][1];
                    v4u w;
                    w.x = pk2(bf2f(y.x & 0xffffu) * sigm_f(v0[0]), bf2f(y.x >> 16) * sigm_f(v0[1]));
                    w.y = pk2(bf2f(y.y & 0xffffu) * sigm_f(v0[2]), bf2f(y.y >> 16) * sigm_f(v0[3]));
                    w.z = pk2(bf2f(y.z & 0xffffu) * sigm_f(v1[0]), bf2f(y.z >> 16) * sigm_f(v1[1]));
                    w.w = pk2(bf2f(y.w & 0xffffu) * sigm_f(v1[2]), bf2f(y.w >> 16) * sigm_f(v1[3]));
                    *(v4u*)(O + r * D + col0 + bj * 128) = w;
                }
            }
    }
};

__device__ __forceinline__ void cvt_item(const float* W, int K, int N, bf16_t* WT, int mode, int row_off, LAS float* scr, int item, int lane) {
    const int nblk = N / 32, kb = item / nblk, nb = item % nblk, k0 = 64 * kb, n0 = 32 * nb;
#pragma unroll 8
    for (int i = 0; i < 32; ++i) { const int kk = 2 * i + (lane >> 5); scr[kk * 33 + (lane & 31)] = W[(size_t)(k0 + kk) * N + n0 + (lane & 31)]; }
    LDS_WAIT(); asm volatile("" ::: "memory");
    const int rbase = (mode == 0) ? (row_off + n0) : (256 * (n0 >> 7) + (n0 & 127) + (mode == 2 ? 128 : 0));
    const int c = lane & 7;
#pragma unroll
    for (int j = 0; j < 4; ++j) { const int n = (lane >> 3) + 8 * j; const LAS float* s = scr + (8 * c) * 33 + n;
        v4u o; o.x = pk2(s[0 * 33], s[1 * 33]); o.y = pk2(s[2 * 33], s[3 * 33]); o.z = pk2(s[4 * 33], s[5 * 33]); o.w = pk2(s[6 * 33], s[7 * 33]);
        *(v4u*)(WT + (size_t)(rbase + n) * K + k0 + 8 * c) = o; }
    LDS_WAIT(); asm volatile("" ::: "memory");
}
__device__ __forceinline__ void convert_ffn(const float* wg, const float* wu, const float* wd, unsigned char* ws, LAS float* scr, int gw, int NGW, int lane) {
    constexpr int I_G = (D / 64) * (DFF / 32), I_D = (DFF / 64) * (D / 32);
    bf16_t* WGU = (bf16_t*)(ws + WS_WGU); bf16_t* WD = (bf16_t*)(ws + WS_WD);
    for (int it = gw; it < 2 * I_G + I_D; it += NGW) {
        if (it < I_G) cvt_item(wg, D, DFF, WGU, 1, 0, scr, it, lane);
        else if (it < 2 * I_G) cvt_item(wu, D, DFF, WGU, 2, 0, scr, it - I_G, lane);
        else cvt_item(wd, DFF, D, WD, 0, 0, scr, it - 2 * I_G, lane);
    }
}
__device__ __forceinline__ void rowpass(const float* y, const float* gpost, float scale, const float* xsrc, float* xdst, const float* gpre, bf16_t* hdst, int gw, int NGW, int lane) {
    for (int m = gw; m < M; m += NGW) {
        f32x4 xv[4];
#pragma unroll
        for (int j = 0; j < 4; ++j) xv[j] = *(const f32x4*)(xsrc + (size_t)m * D + 4 * lane + 256 * j);
        if (y) {
            f32x4 yv[4]; float ss = 0.f;
#pragma unroll
            for (int j = 0; j < 4; ++j) { yv[j] = *(const f32x4*)(y + (size_t)m * D + 4 * lane + 256 * j); ss += (yv[j].x * yv[j].x + yv[j].y * yv[j].y) + (yv[j].z * yv[j].z + yv[j].w * yv[j].w); }
            const float r = scale / sqrtf(wave_sum(ss) * (1.f / D) + EPS);
#pragma unroll
            for (int j = 0; j < 4; ++j) { const f32x4 g = *(const f32x4*)(gpost + 4 * lane + 256 * j); xv[j] += yv[j] * r * g; *(f32x4*)(xdst + (size_t)m * D + 4 * lane + 256 * j) = xv[j]; }
        }
        if (gpre) {
            float ss = 0.f;
#pragma unroll
            for (int j = 0; j < 4; ++j) ss += (xv[j].x * xv[j].x + xv[j].y * xv[j].y) + (xv[j].z * xv[j].z + xv[j].w * xv[j].w);
            const float r = 1.f / sqrtf(wave_sum(ss) * (1.f / D) + EPS);
#pragma unroll
            for (int j = 0; j < 4; ++j) { const f32x4 g = *(const f32x4*)(gpre + 4 * lane + 256 * j); const f32x4 h = xv[j] * r * g;
                v2u w; w.x = pk2(h.x, h.y); w.y = pk2(h.z, h.w); *(v2u*)(hdst + (size_t)m * D + 4 * lane + 256 * j) = w; }
        }
    }
}

struct Args { const float* in[25]; float* out; unsigned char* ws; int ph_lo, ph_hi; };

__device__ __forceinline__ void prologue(const Args& a, LAS unsigned char* lds, int gw, int NGW, int wave, int lane) {
    unsigned char* ws = a.ws;
    LAS float* scr = (LAS float*)(lds + wave * 16384);
    convert_ffn(a.in[2], a.in[3], a.in[4], ws, scr, gw, NGW, lane);
    constexpr int I0 = (D / 64) * (EVEN_IN / 32), I1 = (D / 64) * (D / 32), I2 = (DH / 64) * (DH / 32), I3 = (D / 64) * (ODD_IN / 32), I4 = I1, I5 = 4 * 8;
    for (int it = gw; it < I0 + I1 + I2 + I3 + I4 + I5; it += NGW) {
        int r = it;
        if (r < I0) { cvt_item(a.in[5], D, EVEN_IN, (bf16_t*)(ws + WS_WEIN), 0, 0, scr, r, lane); continue; } r -= I0;
        if (r < I1) { cvt_item(a.in[6], D, D, (bf16_t*)(ws + WS_WEOUT), 0, 0, scr, r, lane); continue; } r -= I1;
        if (r < I2) { cvt_item(a.in[15], DH, DH, (bf16_t*)(ws + WS_WGLU), 0, 0, scr, r, lane); continue; } r -= I2;
        if (r < I3) { cvt_item(a.in[19], D, ODD_IN, (bf16_t*)(ws + WS_WOIN), 0, 0, scr, r, lane); continue; } r -= I3;
        if (r < I4) { cvt_item(a.in[20], D, D, (bf16_t*)(ws + WS_WOOUT), 0, 0, scr, r, lane); continue; } r -= I4;
        { const int gi = r >> 3; cvt_item(a.in[21] + gi * 16384, 128, 128, (bf16_t*)(ws + WS_WPOOL) + gi * 16384, 0, 0, scr, r & 7, lane); }
    }
    const int gt = gw * 64 + lane, NGT = NGW * 64;
    for (int i = gt; i < 4 * 128 * 128; i += NGT) { const int s = i & 127, t = (i >> 7) & 127; ((bf16_t*)(ws + WS_WSGU))[i] = (bf16_t)(s <= t ? f2bf(a.in[17][i]) : 0u); }
    for (int gp = gt; gp < 2048; gp += NGT) {
        const int g = gp >> 6, p = gp & 63;
        const float lr = a.in[7][gp], li = a.in[8][gp], dt = expf(a.in[9][g]);
        const float mag = expf(lr * dt), are = mag * cosf(li * dt), aim = mag * sinf(li * dt), den = lr * lr + li * li;
        const float cre = ((are - 1.f) * lr + aim * li) / den, cim = (aim * lr - (are - 1.f) * li) / den;
        ((float*)(ws + WS_ARE))[gp] = are; ((float*)(ws + WS_AIM))[gp] = aim;
        bf16_t* SB = (bf16_t*)(ws + WS_S5B); bf16_t* SC = (bf16_t*)(ws + WS_S5C);
        for (int c = 0; c < 16; ++c) {
            const float br = a.in[10][gp * 16 + c], bi = a.in[11][gp * 16 + c];
            const float bbr = cre * br - cim * bi, bbi = cre * bi + cim * br;
            ((float*)(ws + WS_BRE))[gp * 16 + c] = bbr; ((float*)(ws + WS_BIM))[gp * 16 + c] = bbi;
            SB[(g * 128 + p) * 16 + c] = (bf16_t)f2bf(bbr); SB[(g * 128 + 64 + p) * 16 + c] = (bf16_t)f2bf(bbi);
            SC[(g * 16 + c) * 128 + p] = (bf16_t)f2bf(a.in[12][(g * 16 + c) * 64 + p]); SC[(g * 16 + c) * 128 + 64 + p] = (bf16_t)f2bf(-a.in[13][(g * 16 + c) * 64 + p]);
        }
    }
    rowpass(nullptr, nullptr, 0.f, a.in[0], nullptr, a.in[1], (bf16_t*)(ws + WS_H), gw, NGW, lane);
}
#ifndef MK_FAST_EVEN
#define MK_FAST_EVEN 0
#endif
#ifndef MK_FAST_ODD
#define MK_FAST_ODD 0
#endif
#define MIX_PHASE_A
#define MIX_PHASE_B
#define MIX_PHASE_C

__global__ void __launch_bounds__(256) sgu_stats_naive(const bf16_t* z, float* stats) {
    const int row = blockIdx.x * 4 + (threadIdx.x >> 6), lane = threadIdx.x & 63;
    const v4u raw = *(const v4u*)(z + (size_t)row * EVEN_IN + 1024 + lane * 8);
    float v[8]; v[0] = gelu_t(bf2f(raw.x & 0xffffu)); v[1] = gelu_t(bf2f(raw.x >> 16)); v[2] = gelu_t(bf2f(raw.y & 0xffffu)); v[3] = gelu_t(bf2f(raw.y >> 16));
    v[4] = gelu_t(bf2f(raw.z & 0xffffu)); v[5] = gelu_t(bf2f(raw.z >> 16)); v[6] = gelu_t(bf2f(raw.w & 0xffffu)); v[7] = gelu_t(bf2f(raw.w >> 16));
    float s = 0.f; for (int i = 0; i < 8; ++i) s += v[i];
    const float mean = wave_sum(s) * (1.f / 512.f); float q = 0.f; for (int i = 0; i < 8; ++i) q += (v[i] - mean) * (v[i] - mean);
    const float var = wave_sum(q) * (1.f / 512.f);
    if (lane == 0) { stats[row * 2] = mean; stats[row * 2 + 1] = 1.f / sqrtf(var + EPS); }
}
__global__ void __launch_bounds__(256) sgu_naive(const bf16_t* z, const float* stats, const float* ng, const float* w, const float* bs, bf16_t* cat) {
    const int idx = blockIdx.x * 256 + threadIdx.x, row = idx >> 9, c = idx & 511, h = c >> 7, tt = row & 127, row0 = row - tt;
    float acc = bs[h * 128 + tt]; const float g = ng[c];
    for (int s = 0; s <= tt; ++s) { const int r = row0 + s; const float vn = (gelu_t(bf2f(z[(size_t)r * EVEN_IN + 1024 + c])) - stats[2 * r]) * stats[2 * r + 1] * g; acc += w[(h * 128 + tt) * 128 + s] * vn; }
    const float u = gelu_t(bf2f(z[(size_t)row * EVEN_IN + 512 + c]));
    cat[(size_t)row * D + 512 + c] = (bf16_t)f2bf(u * acc);
}
__global__ void __launch_bounds__(64) s5_naive(const bf16_t* z, const float* are, const float* aim, const float* bre, const float* bim, const float* cre_in, const float* cim_in, const float* dsk, bf16_t* yapre) {
    const int b = blockIdx.x >> 5, g = blockIdx.x & 31, lane = threadIdx.x, gp = g * 64 + lane;
    float Br[16], Bi[16], Cr[16], Ci[16];
#pragma unroll
    for (int c = 0; c < 16; ++c) { Br[c] = bre[gp * 16 + c]; Bi[c] = bim[gp * 16 + c]; Cr[c] = cre_in[(g * 16 + c) * 64 + lane]; Ci[c] = cim_in[(g * 16 + c) * 64 + lane]; }
    const float ar = are[gp], ai = aim[gp], dv = dsk[g * 16 + (lane & 15)];
    float xr = 0.f, xi = 0.f;
    for (int t = 0; t < SEQ; ++t) {
        const size_t row = (size_t)b * SEQ + t;
        const v4u u0 = *(const v4u*)(z + row * EVEN_IN + g * 16), u1 = *(const v4u*)(z + row * EVEN_IN + g * 16 + 8);
        float u[16];
        u[0] = bf2f(u0.x & 0xffffu); u[1] = bf2f(u0.x >> 16); u[2] = bf2f(u0.y & 0xffffu); u[3] = bf2f(u0.y >> 16); u[4] = bf2f(u0.z & 0xffffu); u[5] = bf2f(u0.z >> 16); u[6] = bf2f(u0.w & 0xffffu); u[7] = bf2f(u0.w >> 16);
        u[8] = bf2f(u1.x & 0xffffu); u[9] = bf2f(u1.x >> 16); u[10] = bf2f(u1.y & 0xffffu); u[11] = bf2f(u1.y >> 16); u[12] = bf2f(u1.z & 0xffffu); u[13] = bf2f(u1.z >> 16); u[14] = bf2f(u1.w & 0xffffu); u[15] = bf2f(u1.w >> 16);
        float bur = 0.f, bui = 0.f;
#pragma unroll
        for (int c = 0; c < 16; ++c) { bur += u[c] * Br[c]; bui += u[c] * Bi[c]; }
        const float nr = ar * xr - ai * xi + bur, ni = ar * xi + ai * xr + bui; xr = nr; xi = ni;
        float myy = 0.f, myu = 0.f;
#pragma unroll
        for (int c = 0; c < 16; ++c) { const float s = wave_sum(xr * Cr[c] - xi * Ci[c]); if (lane == c) { myy = s; myu = u[c]; } }
        if (lane < 16) yapre[row * DH + g * 16 + lane] = (bf16_t)f2bf(gelu_t(myy + dv * myu));
    }
}
__global__ void __launch_bounds__(256) pool_prep_naive(const bf16_t* z, float* A) {
    const int idx = blockIdx.x * 256 + threadIdx.x, row = idx >> 9, c = idx & 511, gi = c >> 7, win = 2 << gi, t = row & (SEQ - 1), cnt = (t + 1) < win ? (t + 1) : win;
    float s = 0.f; for (int j = 0; j < cnt; ++j) s += bf2f(z[(size_t)(row - j) * ODD_IN + c]);
    A[idx] = s / (float)cnt - bf2f(z[(size_t)row * ODD_IN + c]);
}
__global__ void __launch_bounds__(256) pool_naive(const float* A, const float* pw, const float* scale, bf16_t* cat) {
    const int idx = blockIdx.x * 256 + threadIdx.x, row = idx >> 9, c = idx & 511, gi = c >> 7, n = c & 127;
    float acc = 0.f; for (int k = 0; k < 128; ++k) acc += A[(size_t)row * DH + gi * 128 + k] * pw[(gi * 128 + k) * 128 + n];
    cat[(size_t)row * D + c] = (bf16_t)f2bf(acc * scale[c]);
}
__global__ void __launch_bounds__(128) hgrn_naive(const bf16_t* z, const float* lb_in, const float* onorm, bf16_t* cat) {
    __shared__ float qs[128], fs[128], ks[128], red[2];
    const int b = blockIdx.x >> 2, h = blockIdx.x & 3, v = threadIdx.x, d = h * 128 + v, lane = v & 63, wv = v >> 6;
    const float lb = 1.f / (1.f + expf(lb_in[d] - lb_in[512 + d])), og = onorm[v];
    float S[128];
#pragma unroll
    for (int k = 0; k < 128; ++k) S[k] = 0.f;
    for (int t = 0; t < SEQ; ++t) {
        const size_t row = (size_t)b * SEQ + t; const bf16_t* zr = z + row * ODD_IN;
        const float zq = bf2f(zr[512 + d]), zf = bf2f(zr[1024 + d]), zi = bf2f(zr[1536 + d]), zg = bf2f(zr[2048 + d]);
        const float f = lb + (1.f - lb) * sigm_f(zf);
        qs[v] = silu_f(zq); fs[v] = f; ks[v] = 1.f - f;
        __syncthreads();
        float o = 0.f;
#pragma unroll
        for (int k = 0; k < 128; ++k) { S[k] = fs[k] * S[k] + ks[k] * zi; o += qs[k] * S[k]; }
        const float ss = wave_sum(o * o); if (lane == 0) red[wv] = ss;
        __syncthreads();
        const float tot = red[0] + red[1];
        cat[row * D + 512 + d] = (bf16_t)f2bf(o / sqrtf(tot * (1.f / 128.f) + EPS) * og * silu_f(zg));
    }
}

constexpr int N_PHASES = 25;
typedef const __attribute__((address_space(4))) Args* KArgs;
#define FRESH() \
    KArgs ka = (KArgs)__builtin_amdgcn_kernarg_segment_ptr(); asm volatile("" : "+s"(ka)); \
    int tid = threadIdx.x; asm volatile("" : "+v"(tid)); \
    int bid = blockIdx.x; asm volatile("" : "+s"(bid)); \
    int G = gridDim.x; asm volatile("" : "+s"(G)); \
    const int lane = tid & 63, wave = __builtin_amdgcn_readfirstlane(tid >> 6), gw = bid * 8 + wave, NGW = G * 8; \
    unsigned char* ws = ka->ws; (void)lane; (void)gw; (void)NGW; (void)ws
#define WSP(T, off) ((T*)(ws + (off)))

__global__ void __launch_bounds__(512, 2) mega(Args a) {
    extern __shared__ __attribute__((aligned(16))) unsigned char lds_raw[];
    LAS unsigned char* lds = (LAS unsigned char*)lds_raw;
    const int ph_lo = a.ph_lo, ph_hi = a.ph_hi;
    for (int ph = ph_lo; ph < ph_hi; ++ph) {
        if (ph > ph_lo) cg::this_grid().sync();
        if (ph == 0) { FRESH(); Args al; for (int i = 0; i < 25; ++i) al.in[i] = ka->in[i]; al.out = ka->out; al.ws = ka->ws; prologue(al, lds, gw, NGW, wave, lane); continue; }
        const int li = (ph - 1) / 12, k = (ph - 1) % 12;
        switch (k) {
        case 0: case 9: {
            FRESH();
            pg8::Gemm g{WSP(bf16_t, WS_H), WSP(const bf16_t, WS_WGU), M, 2 * DFF, D}; pg8::StaticOrder S; S.init(M, 2 * DFF, G, bid);
            EpiSwiGLU E{WSP(bf16_t, WS_HID)};
            pg8::gemm_phase<EpiSwiGLU, pg8::StaticOrder, PG8_ALIGN, PG8_SP2>(lds, g, S, E, tid);
        } break;
        case 1: case 10: {
            FRESH();
            pg8::Gemm g{WSP(bf16_t, WS_HID), WSP(const bf16_t, WS_WD), M, D, DFF}; pg8::StaticOrder S; S.init(M, D, G, bid);
            EpiF32 E{WSP(float, WS_YFFN), D};
            pg8::gemm_phase<EpiF32, pg8::StaticOrder, PG8_ALIGN, PG8_SP2>(lds, g, S, E, tid);
        } break;
        case 2: { FRESH(); const float* ng = ka->in[1] + (size_t)li * 6 * D;
            rowpass(WSP(float, WS_YFFN), ng + 1 * D, 0.5f, (ph == 3) ? ka->in[0] : ka->out, ka->out, ng + 2 * D, WSP(bf16_t, WS_H), gw, NGW, lane); } break;
        case 3: {
            FRESH();
            const int N = li == 0 ? EVEN_IN : ODD_IN;
            pg8::Gemm g{WSP(bf16_t, WS_H), (const bf16_t*)(ws + (li == 0 ? WS_WEIN : WS_WOIN)), M, N, D}; pg8::StaticOrder S; S.init(M, N, G, bid);
            EpiBf E{WSP(bf16_t, WS_Z), N};
            pg8::gemm_phase<EpiBf, pg8::StaticOrder, PG8_ALIGN, PG8_SP2>(lds, g, S, E, tid);
        } break;
        case 4: { MIX_PHASE_A } break;
        case 5: { MIX_PHASE_B } break;
        case 6: {
            if (li == 0) {
                FRESH();
                pg8::Gemm g{WSP(bf16_t, WS_YAPRE), WSP(const bf16_t, WS_WGLU), M, DH, DH}; pg8::StaticOrder S; S.init(M, DH, G, bid);
                EpiGLU E{WSP(const bf16_t, WS_YAPRE), WSP(bf16_t, WS_CAT)};
                pg8::gemm_phase<EpiGLU, pg8::StaticOrder, PG8_ALIGN, PG8_SP2>(lds, g, S, E, tid);
            } else { MIX_PHASE_C }
        } break;
        case 7: {
            FRESH();
            pg8::Gemm g{WSP(bf16_t, WS_CAT), (const bf16_t*)(ws + (li == 0 ? WS_WEOUT : WS_WOOUT)), M, D, D}; pg8::StaticOrder S; S.init(M, D, G, bid);
            EpiF32 E{WSP(float, WS_YMIX), D};
            pg8::gemm_phase<EpiF32, pg8::StaticOrder, PG8_ALIGN, PG8_SP2>(lds, g, S, E, tid);
        } break;
        case 8: {
            FRESH(); const float* ng = ka->in[1] + (size_t)li * 6 * D;
            rowpass(WSP(float, WS_YMIX), ng + 3 * D, 1.0f, ka->out, ka->out, ng + 4 * D, WSP(bf16_t, WS_H), gw, NGW, lane);
            const size_t o = (size_t)(li * 2 + 1) * D * DFF;
            convert_ffn(ka->in[2] + o, ka->in[3] + o, ka->in[4] + o, ws, (LAS float*)(lds + wave * 16384), gw, NGW, lane);
        } break;
        case 11: {
            FRESH(); const float* ng = ka->in[1] + (size_t)li * 6 * D;
            rowpass(WSP(float, WS_YFFN), ng + 5 * D, 0.5f, ka->out, ka->out, li < 1 ? ka->in[1] + (size_t)(li + 1) * 6 * D : nullptr, WSP(bf16_t, WS_H), gw, NGW, lane);
            if (li < 1) { const size_t o = (size_t)((li + 1) * 2) * D * DFF;
                convert_ffn(ka->in[2] + o, ka->in[3] + o, ka->in[4] + o, ws, (LAS float*)(lds + wave * 16384), gw, NGW, lane); }
        } break;
        default: break;
        }
    }
}

#ifndef MK_ONE_LAUNCH
#define MK_ONE_LAUNCH 0
#endif
extern "C" void kernel_launch(void* const* d_in, const int* in_sizes, int n_in, void* d_out, int out_size, void* d_ws, size_t ws_size, hipStream_t stream) {
    static int grid = 0;
    if (grid == 0) {
        if (hipFuncSetAttribute((const void*)mega, hipFuncAttributeMaxDynamicSharedMemorySize, LDS_BYTES) != hipSuccess) { fprintf(stderr, "kernel_launch: hipFuncSetAttribute failed\n"); grid = -1; return; }
        int dev = 0, cus = 0, per_cu = 0;
        (void)hipGetDevice(&dev); (void)hipDeviceGetAttribute(&cus, hipDeviceAttributeMultiprocessorCount, dev);
        (void)hipOccupancyMaxActiveBlocksPerMultiprocessor(&per_cu, (const void*)mega, 512, LDS_BYTES);
        if (per_cu < 1) per_cu = 1;
        if (cus < 1) cus = 256;
        grid = cus * per_cu;
        (void)hipGetLastError();
    }
    if (grid < 0) return;
    Args a{};
    for (int i = 0; i < 25; ++i) a.in[i] = (const float*)d_in[i];
    a.out = (float*)d_out; a.ws = (unsigned char*)d_ws;
    unsigned char* ws = (unsigned char*)d_ws;
#if MK_ONE_LAUNCH
    a.ph_lo = 0; a.ph_hi = N_PHASES;
    void* args[] = {&a};
    hipError_t e = hipLaunchCooperativeKernel((const void*)mega, dim3(grid), dim3(512), args, LDS_BYTES, stream);
    if (e != hipSuccess) fprintf(stderr, "cooperative launch failed: %s (grid %d)\n", hipGetErrorString(e), grid);
#else
    auto run = [&](int lo, int hi) { a.ph_lo = lo; a.ph_hi = hi; hipLaunchKernelGGL(mega, dim3(grid), dim3(512), LDS_BYTES, stream, a); };
    const bf16_t* Zp = (const bf16_t*)(ws + WS_Z); bf16_t* CATp = (bf16_t*)(ws + WS_CAT);
    for (int ph = 0; ph < N_PHASES; ++ph) {
        const int li = ph == 0 ? 0 : (ph - 1) / 12, k = ph == 0 ? -1 : (ph - 1) % 12;
#if !MK_FAST_EVEN
        if (k == 4 && li == 0) {
            sgu_stats_naive<<<M / 4, 256, 0, stream>>>(Zp, (float*)(ws + WS_STATS));
            sgu_naive<<<M * 512 / 256, 256, 0, stream>>>(Zp, (const float*)(ws + WS_STATS), a.in[16], a.in[17], a.in[18], CATp);
            s5_naive<<<128, 64, 0, stream>>>(Zp, (const float*)(ws + WS_ARE), (const float*)(ws + WS_AIM), (const float*)(ws + WS_BRE), (const float*)(ws + WS_BIM), a.in[12], a.in[13], a.in[14], (bf16_t*)(ws + WS_YAPRE));
            continue;
        }
        if (k == 5 && li == 0) continue;
#endif
#if !MK_FAST_ODD
        if (k == 4 && li == 1) {
            pool_prep_naive<<<M * 512 / 256, 256, 0, stream>>>(Zp, (float*)(ws + WS_POOLA));
            pool_naive<<<M * 512 / 256, 256, 0, stream>>>((const float*)(ws + WS_POOLA), a.in[21], a.in[22], CATp);
            hgrn_naive<<<16, 128, 0, stream>>>(Zp, a.in[23], a.in[24], CATp);
            continue;
        }
        if ((k == 5 || k == 6) && li == 1) continue;
#endif
        run(ph, ph + 1);
    }
#endif
}
```

```cpp
#include <hip/hip_runtime.h>
#include <hip/hip_cooperative_groups.h>
#include <cstdio>
#include <cstdint>
namespace cg = cooperative_groups;
namespace pg8 {
#define PG8_LAS __attribute__((address_space(3)))
typedef unsigned short bf16_t;
typedef short bf16x8 __attribute__((ext_vector_type(8)));
typedef float f32x4 __attribute__((ext_vector_type(4)));
typedef unsigned u32x4 __attribute__((ext_vector_type(4)));
constexpr int BM = 256, BK = 64, HALF = 128, HTB = HALF * BK * 2  , STAGE_BYTES = 8 * HTB, NXCD = 8, WGM = 8;

__host__ __device__ __forceinline__ int lds_byte(int r, int c) { const int st = (r >> 4) * 2 + (c >> 5), rr = r & 15, cc = c & 31, ob = rr * 64 + cc * 2; return st * 1024 + (ob ^ (((ob >> 9) & 1) << 5)); }
__host__ __device__ __forceinline__ void stage_rc(int b, int& R, int& C) { const int st = b / 1024, sb = b % 1024, swz = sb ^ (((sb >> 9) & 1) << 5); R = (st >> 1) * 16 + swz / 64; C = (st & 1) * 32 + (swz % 64) / 2; }
__host__ __device__ __forceinline__ int perm32(int rho) { const int n = rho >> 4, i = rho & 15; return 8 * (i >> 2) + 4 * n + (i & 3); }

struct Unit { int pm, pn; };
struct Gemm { const bf16_t* A; const bf16_t* Bt; int M, N, K; };

struct StaticOrder {
    int nM, nN, nwg, G, c;
    __host__ __device__ void init(int M, int N, int G_, int c_) { nM = M / BM; nN = N / BM; nwg = nM * nN; G = G_; c = c_; }
    __host__ __device__ bool next(int i, Unit& u) const {
        const long L = (long)i * G + c; if (L >= nwg) return false;
        int wgid = (int)L; { const int q = nwg / NXCD, r = nwg % NXCD, xcd = wgid % NXCD, off = wgid / NXCD; wgid = (xcd < r ? xcd * (q + 1) : r * (q + 1) + (xcd - r) * q) + off; }
        const int nig = WGM * nN, gid = wgid / nig, fm = gid * WGM, gsz = (nM - fm) < WGM ? (nM - fm) : WGM;
        u.pm = fm + ((wgid % nig) % gsz); u.pn = (wgid % nig) / gsz; return true;
    }
    __device__ __forceinline__ void a_ready(const Unit&) const {}
    __device__ __forceinline__ void done(const Unit&) const {}
};

__device__ __forceinline__ unsigned cvt_pk_bf16(float lo, float hi) { unsigned r; asm volatile("v_cvt_pk_bf16_f32 %0, %1, %2" : "=v"(r) : "v"(lo), "v"(hi)); return r; }
typedef float f32x2 __attribute__((ext_vector_type(2)));
template <class Epi, class Sched, bool ALIGN_EPI = false, bool SP2 = false>
__device__ __forceinline__ void gemm_phase(PG8_LAS unsigned char* lds, const Gemm g, const Sched& S, const Epi& E, const int tid_in) {
    const int tid = tid_in, wid = __builtin_amdgcn_readfirstlane(tid >> 6), lane = tid & 63, wr = wid >> 2, wc = wid & 3, fr = lane & 15, fq = lane >> 4;
    const int K = g.K, nt = K / BK;
    unsigned voffA[2], voffB[2];
#pragma unroll
    for (int i = 0; i < 2; ++i) { int R, C; stage_rc(tid * 16 + i * 8192, R, C); const int Rb = Epi::PERM ? ((R & ~31) + perm32(R & 31)) : R;
        voffA[i] = (unsigned)(R * K + C) * 2u; voffB[i] = (unsigned)(Rb * K + C) * 2u; }
    const size_t kstep = (size_t)(BK * 2);
    const size_t hstep = (size_t)HALF * K * 2;
    const size_t tstep = 2 * hstep;
    const unsigned ldsw = (unsigned)wid * 1024u;
    const int aoff = lds_byte(wr * 64 + fr, fq * 8), boff = lds_byte(wc * 32 + fr, fq * 8);
#define PG8_SA(b, h) (((b) * 2 + (h)) * HTB)
#define PG8_SB(b, h) ((4 + (b) * 2 + (h)) * HTB)
#define PG8_STAGE(bufoff, gbase, voff) do { _Pragma("unroll") for (int _i = 0; _i < 2; ++_i) \
        __builtin_amdgcn_global_load_lds((const unsigned*)((const char*)(gbase) + (voff)[_i]), (PG8_LAS unsigned*)(lds + (bufoff) + ldsw + _i * 8192), 16, 0, 0); } while (0)
#define PG8_LDA(dst, b, h) do { _Pragma("unroll") for (int m = 0; m < 4; ++m) _Pragma("unroll") for (int k = 0; k < 2; ++k) dst[m][k] = *(const PG8_LAS bf16x8*)(lds + PG8_SA(b, h) + aoff + m * 2048 + k * 1024); } while (0)
#define PG8_LDB(dst, b, h) do { _Pragma("unroll") for (int n = 0; n < 2; ++n) _Pragma("unroll") for (int k = 0; k < 2; ++k) dst[n][k] = *(const PG8_LAS bf16x8*)(lds + PG8_SB(b, h) + boff + n * 2048 + k * 1024); } while (0)
#define PG8_MMA(ai, bj, At, Bt) do { __builtin_amdgcn_s_setprio(1); _Pragma("unroll") for (int m = 0; m < 4; ++m) _Pragma("unroll") for (int n = 0; n < 2; ++n) _Pragma("unroll") for (int k = 0; k < 2; ++k) \
        acc[ai][bj][m][n] = __builtin_amdgcn_mfma_f32_16x16x32_bf16(Bt[n][k], At[m][k], acc[ai][bj][m][n], 0, 0, 0); __builtin_amdgcn_s_setprio(0); } while (0)
#define PG8_WAIT_V(n) asm volatile("s_waitcnt vmcnt(" #n ")" ::: "memory")
#define PG8_WAIT_L(n) asm volatile("s_waitcnt lgkmcnt(" #n ")" ::: "memory")
#define PG8_BAR __builtin_amdgcn_s_barrier()
#define PG8_SCHED __builtin_amdgcn_sched_barrier(0)
    Unit cur, nxt; int ui = 0;
    if (!S.next(0, cur)) return;
    f32x4 acc[2][2][4][2];
#pragma unroll
    for (int a = 0; a < 2; ++a)
#pragma unroll
        for (int b = 0; b < 2; ++b)
#pragma unroll
            for (int m = 0; m < 4; ++m)
#pragma unroll
                for (int n = 0; n < 2; ++n) acc[a][b][m][n] = (f32x4){0.f, 0.f, 0.f, 0.f};
    bf16x8 At[4][2], B0[2][2], B1[2][2];
    const char* cA = (const char*)g.A + (size_t)cur.pm * tstep; const char* cB = (const char*)g.Bt + (size_t)cur.pn * tstep;
    S.a_ready(cur);
    if constexpr (SP2) {
        PG8_STAGE(PG8_SB(0, 0), cB, voffB); PG8_STAGE(PG8_SB(0, 1), cB + hstep, voffB); PG8_STAGE(PG8_SA(0, 0), cA, voffA); PG8_STAGE(PG8_SA(0, 1), cA + hstep, voffA);
        if (wr == 1) PG8_BAR;
        PG8_WAIT_V(2); PG8_BAR;
        PG8_STAGE(PG8_SB(1, 0), cB + kstep, voffB); PG8_STAGE(PG8_SA(1, 0), cA + kstep, voffA); PG8_STAGE(PG8_SB(1, 1), cB + hstep + kstep, voffB);
        PG8_WAIT_V(6); PG8_BAR;
    } else {
        PG8_STAGE(PG8_SB(0, 0), cB, voffB); PG8_STAGE(PG8_SA(0, 0), cA, voffA); PG8_STAGE(PG8_SB(0, 1), cB + hstep, voffB); PG8_STAGE(PG8_SA(0, 1), cA + hstep, voffA);
        if (wr == 1) PG8_BAR;
        PG8_WAIT_V(4); PG8_BAR;
        PG8_STAGE(PG8_SB(1, 0), cB + kstep, voffB); PG8_STAGE(PG8_SA(1, 0), cA + kstep, voffA); PG8_STAGE(PG8_SB(1, 1), cB + hstep + kstep, voffB);
        PG8_WAIT_V(6); PG8_BAR;
    }
    for (;;) {
        const bool has_next = S.next(ui + 1, nxt);
        const char* nA = has_next ? (const char*)g.A + (size_t)nxt.pm * tstep : cA; const char* nB = has_next ? (const char*)g.Bt + (size_t)nxt.pn * tstep : cB;
        for (int t = 0; t < nt; t += 2) {
            const bool last = (t == nt - 2);
            const char* a1 = cA + (size_t)(t + 1) * kstep;
            const char* a2 = last ? nA : cA + (size_t)(t + 2) * kstep; const char* b2 = last ? nB : cB + (size_t)(t + 2) * kstep;
            const char* a3 = a2 + kstep; const char* b3 = b2 + kstep;
            if (last && has_next) S.a_ready(nxt);
            if constexpr (SP2) {
            PG8_LDB(B0, 0, 0); PG8_LDB(B1, 0, 1); PG8_SCHED; PG8_LDA(At, 0, 0); PG8_STAGE(PG8_SA(1, 1), a1 + hstep, voffA);
            PG8_WAIT_V(8); PG8_WAIT_L(0); PG8_BAR; PG8_MMA(0, 0, At, B0); PG8_MMA(0, 1, At, B1); PG8_BAR; PG8_SCHED;
            PG8_LDA(At, 0, 1); PG8_STAGE(PG8_SB(0, 0), b2, voffB); PG8_STAGE(PG8_SB(0, 1), b2 + hstep, voffB); PG8_STAGE(PG8_SA(0, 0), a2, voffA);
            PG8_WAIT_V(8); PG8_WAIT_L(0); PG8_BAR; PG8_MMA(1, 0, At, B0); PG8_MMA(1, 1, At, B1); PG8_BAR; PG8_SCHED;
            PG8_LDB(B0, 1, 0); PG8_LDB(B1, 1, 1); PG8_SCHED; PG8_LDA(At, 1, 0); PG8_STAGE(PG8_SA(0, 1), a2 + hstep, voffA);
            PG8_WAIT_V(8); PG8_WAIT_L(0); PG8_BAR; PG8_MMA(0, 0, At, B0); PG8_MMA(0, 1, At, B1); PG8_BAR; PG8_SCHED;
            PG8_LDA(At, 1, 1); PG8_STAGE(PG8_SB(1, 0), b3, voffB); PG8_STAGE(PG8_SB(1, 1), b3 + hstep, voffB); PG8_STAGE(PG8_SA(1, 0), a3, voffA);
            PG8_WAIT_V(8); PG8_WAIT_L(0); PG8_BAR; PG8_MMA(1, 0, At, B0); PG8_MMA(1, 1, At, B1); PG8_BAR; PG8_SCHED;
            } else {
            PG8_LDB(B0, 0, 0); PG8_SCHED; PG8_LDA(At, 0, 0); PG8_STAGE(PG8_SA(1, 1), a1 + hstep, voffA);
            PG8_WAIT_L(8); PG8_BAR; PG8_WAIT_L(0); PG8_MMA(0, 0, At, B0); PG8_BAR; PG8_SCHED;
            PG8_LDB(B1, 0, 1); PG8_STAGE(PG8_SB(0, 0), b2, voffB);
            PG8_BAR; PG8_WAIT_L(0); PG8_MMA(0, 1, At, B1); PG8_BAR;
            PG8_LDA(At, 0, 1); PG8_STAGE(PG8_SA(0, 0), a2, voffA);
            PG8_BAR; PG8_WAIT_L(0); PG8_MMA(1, 0, At, B0); PG8_BAR; PG8_SCHED;
            PG8_STAGE(PG8_SB(0, 1), b2 + hstep, voffB);
            PG8_WAIT_V(6); PG8_BAR; PG8_MMA(1, 1, At, B1); PG8_BAR;
            PG8_LDB(B0, 1, 0); PG8_SCHED; PG8_LDA(At, 1, 0); PG8_STAGE(PG8_SA(0, 1), a2 + hstep, voffA);
            PG8_WAIT_L(8); PG8_BAR; PG8_WAIT_L(0); PG8_MMA(0, 0, At, B0); PG8_BAR; PG8_SCHED;
            PG8_LDB(B1, 1, 1); PG8_STAGE(PG8_SB(1, 0), b3, voffB);
            PG8_BAR; PG8_WAIT_L(0); PG8_MMA(0, 1, At, B1); PG8_BAR;
            PG8_LDA(At, 1, 1); PG8_STAGE(PG8_SA(1, 0), a3, voffA);
            PG8_BAR; PG8_WAIT_L(0); PG8_MMA(1, 0, At, B0); PG8_BAR; PG8_SCHED;
            PG8_STAGE(PG8_SB(1, 1), b3 + hstep, voffB);
            PG8_WAIT_V(6); PG8_BAR; PG8_MMA(1, 1, At, B1); PG8_BAR;
            }
        }
        if constexpr (ALIGN_EPI) { if (wr == 0) PG8_BAR; }
        if constexpr (!Epi::AFTER_DRAIN) { E(acc, cur, wr, wc, fr, fq); S.done(cur); }
        if (!has_next) break;
#pragma unroll
        for (int a = 0; a < 2; ++a)
#pragma unroll
            for (int b = 0; b < 2; ++b)
#pragma unroll
                for (int m = 0; m < 4; ++m)
#pragma unroll
                    for (int n = 0; n < 2; ++n) acc[a][b][m][n] = (f32x4){0.f, 0.f, 0.f, 0.f};
        cur = nxt; cA = nA; cB = nB; ++ui;
        if constexpr (ALIGN_EPI) { if (wr == 1) PG8_BAR; }
    }
    PG8_WAIT_V(0);
    if constexpr (!ALIGN_EPI) { if (wr == 0) PG8_BAR; }
    PG8_BAR;
    if constexpr (Epi::AFTER_DRAIN) { E.fused(acc, cur, wr, wc, fr, fq, lds, wid, lane); S.done(cur); }
#undef PG8_SA
#undef PG8_SB
#undef PG8_STAGE
#undef PG8_LDA
#undef PG8_LDB
#undef PG8_MMA
#undef PG8_WAIT_V
#undef PG8_WAIT_L
#undef PG8_BAR
#undef PG8_SCHED
}
}

#ifndef PG8_SP2
#define PG8_SP2 true
#endif
#ifndef PG8_ALIGN
#define PG8_ALIGN true
#endif

#define LAS __attribute__((address_space(3)))
typedef unsigned short bf16_t;
typedef unsigned v4u __attribute__((ext_vector_type(4)));
typedef unsigned v2u __attribute__((ext_vector_type(2)));
typedef float f32x4 __attribute__((ext_vector_type(4)));
typedef short bf16x8 __attribute__((ext_vector_type(8)));

constexpr int M = 16384, D = 1024, SEQ = 4096, DFF = 2816, DH = 512, EVEN_IN = 1536, ODD_IN = 2560;
constexpr float EPS = 1e-6f;
constexpr size_t MiB = 1u << 20;
constexpr size_t WS_ARE = 0, WS_AIM = 8192, WS_BRE = 16384, WS_BIM = 16384 + 131072;
constexpr size_t WS_S5B = 320 * 1024;
constexpr size_t WS_S5C = 448 * 1024;
constexpr size_t WS_STATS = 576 * 1024;
constexpr size_t WS_WGU = 1 * MiB, WS_WD = 12 * MiB;
constexpr size_t WS_WEIN = 18 * MiB, WS_WEOUT = 21 * MiB, WS_WGLU = 23 * MiB, WS_WOIN = 24 * MiB, WS_WOOUT = 29 * MiB;
constexpr size_t WS_WPOOL = 31 * MiB, WS_WSGU = 31 * MiB + 128 * 1024;
constexpr size_t WS_H = 32 * MiB;
constexpr size_t WS_HID = 64 * MiB, WS_YFFN = 152 * MiB;
constexpr size_t WS_Z = 64 * MiB, WS_YAPRE = 112 * MiB, WS_KV = 144 * MiB, WS_CAT = 176 * MiB, WS_YMIX = 64 * MiB, WS_POOLA = 208 * MiB;
constexpr size_t WS_DL = 240 * MiB;
constexpr int LDS_BYTES = 147456;

__device__ __forceinline__ float bf2f(unsigned h) { return __uint_as_float(h << 16); }
__device__ __forceinline__ unsigned f2bf(float f) { unsigned u = __float_as_uint(f); return (u + 0x7fffu + ((u >> 16) & 1u)) >> 16; }
__device__ __forceinline__ unsigned pk2(float lo, float hi) { return f2bf(lo) | (f2bf(hi) << 16); }
__device__ __forceinline__ float gelu_t(float x) { const float u = 0.7978845608f * (x + 0.044715f * x * x * x); return x / (1.f + __expf(-2.f * u)); }
__device__ __forceinline__ float silu_f(float x) { return x / (1.f + __expf(-x)); }
__device__ __forceinline__ float sigm_f(float x) { return 1.f / (1.f + __expf(-x)); }
__device__ __forceinline__ float wave_sum(float v) {
#pragma unroll
    for (int o = 1; o < 64; o <<= 1) v += __shfl_xor(v, o);
    return v;
}
#define LDS_WAIT() asm volatile("s_waitcnt lgkmcnt(0)" ::: "memory")

struct EpiSwiGLU {
    static constexpr bool PERM = true, AFTER_DRAIN = false; bf16_t* O;
    __device__ __forceinline__ void operator()(const pg8::f32x4 (&acc)[2][2][4][2], const pg8::Unit& u, int wr, int wc, int fr, int fq) const {
        const int row0 = u.pm * 256 + wr * 64 + fr, col0 = u.pn * 128 + wc * 32 + 8 * fq;
#pragma unroll
        for (int ai = 0; ai < 2; ++ai)
#pragma unroll
            for (int m = 0; m < 4; ++m) {
                bf16_t* rowp = O + (size_t)(row0 + ai * 128 + m * 16) * DFF + col0;
                const pg8::f32x4 g0 = acc[ai][0][m][0], g1 = acc[ai][0][m][1], u0 = acc[ai][1][m][0], u1 = acc[ai][1][m][1];
                v4u w;
                w.x = pk2(silu_f(g0[0]) * u0[0], silu_f(g0[1]) * u0[1]); w.y = pk2(silu_f(g0[2]) * u0[2], silu_f(g0[3]) * u0[3]);
                w.z = pk2(silu_f(g1[0]) * u1[0], silu_f(g1[1]) * u1[1]); w.w = pk2(silu_f(g1[2]) * u1[2], silu_f(g1[3]) * u1[3]);
                *(v4u*)rowp = w;
            }
    }
};
struct EpiF32 {
    static constexpr bool PERM = false, AFTER_DRAIN = false; float* O; int ldc;
    __device__ __forceinline__ void operator()(const pg8::f32x4 (&acc)[2][2][4][2], const pg8::Unit& u, int wr, int wc, int fr, int fq) const {
        const int row0 = u.pm * 256 + wr * 64 + fr, col0 = u.pn * 256 + wc * 32 + 4 * fq;
#pragma unroll
        for (int ai = 0; ai < 2; ++ai)
#pragma unroll
            for (int m = 0; m < 4; ++m) {
                float* rowp = O + (size_t)(row0 + ai * 128 + m * 16) * ldc + col0;
#pragma unroll
                for (int bj = 0; bj < 2; ++bj)
#pragma unroll
                    for (int n = 0; n < 2; ++n) *(pg8::f32x4*)(rowp + bj * 128 + n * 16) = acc[ai][bj][m][n];
            }
    }
};
struct EpiBf {
    static constexpr bool PERM = true, AFTER_DRAIN = false; bf16_t* O; int ldc;
    __device__ __forceinline__ void operator()(const pg8::f32x4 (&acc)[2][2][4][2], const pg8::Unit& u, int wr, int wc, int fr, int fq) const {
        const int row0 = u.pm * 256 + wr * 64 + fr, col0 = u.pn * 256 + wc * 32 + 8 * fq;
#pragma unroll
        for (int ai = 0; ai < 2; ++ai)
#pragma unroll
            for (int m = 0; m < 4; ++m) {
                bf16_t* rowp = O + (size_t)(row0 + ai * 128 + m * 16) * ldc + col0;
#pragma unroll
                for (int bj = 0; bj < 2; ++bj) {
                    const pg8::f32x4 v0 = acc[ai][bj][m][0], v1 = acc[ai][bj][m][1];
                    v4u w; w.x = pk2(v0[0], v0[1]); w.y = pk2(v0[2], v0[3]); w.z = pk2(v1[0], v1[1]); w.w = pk2(v1[2], v1[3]);
                    *(v4u*)(rowp + bj * 128) = w;
                }
            }
    }
};
struct EpiGLU {
    static constexpr bool PERM = true, AFTER_DRAIN = false; const bf16_t* Y; bf16_t* O;
    __device__ __forceinline__ void operator()(const pg8::f32x4 (&acc)[2][2][4][2], const pg8::Unit& u, int wr, int wc, int fr, int fq) const {
        const int row0 = u.pm * 256 + wr * 64 + fr, col0 = u.pn * 256 + wc * 32 + 8 * fq;
#pragma unroll
        for (int ai = 0; ai < 2; ++ai)
#pragma unroll
            for (int m = 0; m < 4; ++m) {
                const size_t r = (size_t)(row0 + ai * 128 + m * 16);
#pragma unroll
                for (int bj = 0; bj < 2; ++bj) {
                    const v4u y = *(const v4u*)(Y + r * DH + col0 + bj * 128);
                    const pg8::f32x4 v0 = acc[ai][bj][m][0], v1 = acc[ai][bj][m][1];
                    v4u w;
                    w.x = pk2(bf2f(y.x & 0xffffu) * sigm_f(v0[0]), bf2f(y.x >> 16) * sigm_f(v0[1]));
                    w.y = pk2(bf2f(y.y & 0xffffu) * sigm_f(v0[2]), bf2f(y.y >> 16) * sigm_f(v0[3]));
                    w.z = pk2(bf2f(y.z & 0xffffu) * sigm_f(v1[0]), bf2f(y.z >> 16) * sigm_f(v1[1]));
                    w.w = pk2(bf2f(y.w & 0xffffu) * sigm_f(v1[2]), bf2f(y.w >> 16) * sigm_f(v1[3]));
                    *(v4u*)(O + r * D + col0 + bj * 128) = w;
                }
            }
    }
};

__device__ __forceinline__ void cvt_item(const float* W, int K, int N, bf16_t* WT, int mode, int row_off, LAS float* scr, int item, int lane) {
    const int nblk = N / 32, kb = item / nblk, nb = item % nblk, k0 = 64 * kb, n0 = 32 * nb;
#pragma unroll 8
    for (int i = 0; i < 32; ++i) { const int kk = 2 * i + (lane >> 5); scr[kk * 33 + (lane & 31)] = W[(size_t)(k0 + kk) * N + n0 + (lane & 31)]; }
    LDS_WAIT(); asm volatile("" ::: "memory");
    const int rbase = (mode == 0) ? (row_off + n0) : (256 * (n0 >> 7) + (n0 & 127) + (mode == 2 ? 128 : 0));
    const int c = lane & 7;
#pragma unroll
    for (int j = 0; j < 4; ++j) { const int n = (lane >> 3) + 8 * j; const LAS float* s = scr + (8 * c) * 33 + n;
        v4u o; o.x = pk2(s[0 * 33], s[1 * 33]); o.y = pk2(s[2 * 33], s[3 * 33]); o.z = pk2(s[4 * 33], s[5 * 33]); o.w = pk2(s[6 * 33], s[7 * 33]);
        *(v4u*)(WT + (size_t)(rbase + n) * K + k0 + 8 * c) = o; }
    LDS_WAIT(); asm volatile("" ::: "memory");
}
__device__ __forceinline__ void convert_ffn(const float* wg, const float* wu, const float* wd, unsigned char* ws, LAS float* scr, int gw, int NGW, int lane) {
    constexpr int I_G = (D / 64) * (DFF / 32), I_D = (DFF / 64) * (D / 32);
    bf16_t* WGU = (bf16_t*)(ws + WS_WGU); bf16_t* WD = (bf16_t*)(ws + WS_WD);
    for (int it = gw; it < 2 * I_G + I_D; it += NGW) {
        if (it < I_G) cvt_item(wg, D, DFF, WGU, 1, 0, scr, it, lane);
        else if (it < 2 * I_G) cvt_item(wu, D, DFF, WGU, 2, 0, scr, it - I_G, lane);
        else cvt_item(wd, DFF, D, WD, 0, 0, scr, it - 2 * I_G, lane);
    }
}
__device__ __forceinline__ void rowpass(const float* y, const float* gpost, float scale, const float* xsrc, float* xdst, const float* gpre, bf16_t* hdst, int gw, int NGW, int lane) {
    for (int m = gw; m < M; m += NGW) {
        f32x4 xv[4];
#pragma unroll
        for (int j = 0; j < 4; ++j) xv[j] = *(const f32x4*)(xsrc + (size_t)m * D + 4 * lane + 256 * j);
        if (y) {
            f32x4 yv[4]; float ss = 0.f;
#pragma unroll
            for (int j = 0; j < 4; ++j) { yv[j] = *(const f32x4*)(y + (size_t)m * D + 4 * lane + 256 * j); ss += (yv[j].x * yv[j].x + yv[j].y * yv[j].y) + (yv[j].z * yv[j].z + yv[j].w * yv[j].w); }
            const float r = scale / sqrtf(wave_sum(ss) * (1.f / D) + EPS);
#pragma unroll
            for (int j = 0; j < 4; ++j) { const f32x4 g = *(const f32x4*)(gpost + 4 * lane + 256 * j); xv[j] += yv[j] * r * g; *(f32x4*)(xdst + (size_t)m * D + 4 * lane + 256 * j) = xv[j]; }
        }
        if (gpre) {
            float ss = 0.f;
#pragma unroll
            for (int j = 0; j < 4; ++j) ss += (xv[j].x * xv[j].x + xv[j].y * xv[j].y) + (xv[j].z * xv[j].z + xv[j].w * xv[j].w);
            const float r = 1.f / sqrtf(wave_sum(ss) * (1.f / D) + EPS);
#pragma unroll
            for (int j = 0; j < 4; ++j) { const f32x4 g = *(const f32x4*)(gpre + 4 * lane + 256 * j); const f32x4 h = xv[j] * r * g;
                v2u w; w.x = pk2(h.x, h.y); w.y = pk2(h.z, h.w); *(v2u*)(hdst + (size_t)m * D + 4 * lane + 256 * j) = w; }
        }
    }
}

struct Args { const float* in[25]; float* out; unsigned char* ws; int ph_lo, ph_hi; };

__device__ __forceinline__ void prologue(const Args& a, LAS unsigned char* lds, int gw, int NGW, int wave, int lane) {
    unsigned char* ws = a.ws;
    LAS float* scr = (LAS float*)(lds + wave * 16384);
    convert_ffn(a.in[2], a.in[3], a.in[4], ws, scr, gw, NGW, lane);
    constexpr int I0 = (D / 64) * (EVEN_IN / 32), I1 = (D / 64) * (D / 32), I2 = (DH / 64) * (DH / 32), I3 = (D / 64) * (ODD_IN / 32), I4 = I1, I5 = 4 * 8;
    for (int it = gw; it < I0 + I1 + I2 + I3 + I4 + I5; it += NGW) {
        int r = it;
        if (r < I0) { cvt_item(a.in[5], D, EVEN_IN, (bf16_t*)(ws + WS_WEIN), 0, 0, scr, r, lane); continue; } r -= I0;
        if (r < I1) { cvt_item(a.in[6], D, D, (bf16_t*)(ws + WS_WEOUT), 0, 0, scr, r, lane); continue; } r -= I1;
        if (r < I2) { cvt_item(a.in[15], DH, DH, (bf16_t*)(ws + WS_WGLU), 0, 0, scr, r, lane); continue; } r -= I2;
        if (r < I3) { cvt_item(a.in[19], D, ODD_IN, (bf16_t*)(ws + WS_WOIN), 0, 0, scr, r, lane); continue; } r -= I3;
        if (r < I4) { cvt_item(a.in[20], D, D, (bf16_t*)(ws + WS_WOOUT), 0, 0, scr, r, lane); continue; } r -= I4;
        { const int gi = r >> 3; cvt_item(a.in[21] + gi * 16384, 128, 128, (bf16_t*)(ws + WS_WPOOL) + gi * 16384, 0, 0, scr, r & 7, lane); }
    }
    const int gt = gw * 64 + lane, NGT = NGW * 64;
    for (int i = gt; i < 4 * 128 * 128; i += NGT) { const int s = i & 127, t = (i >> 7) & 127; ((bf16_t*)(ws + WS_WSGU))[i] = (bf16_t)(s <= t ? f2bf(a.in[17][i]) : 0u); }
    for (int gp = gt; gp < 2048; gp += NGT) {
        const int g = gp >> 6, p = gp & 63;
        const float lr = a.in[7][gp], li = a.in[8][gp], dt = expf(a.in[9][g]);
        const float mag = expf(lr * dt), are = mag * cosf(li * dt), aim = mag * sinf(li * dt), den = lr * lr + li * li;
        const float cre = ((are - 1.f) * lr + aim * li) / den, cim = (aim * lr - (are - 1.f) * li) / den;
        ((float*)(ws + WS_ARE))[gp] = are; ((float*)(ws + WS_AIM))[gp] = aim;
        bf16_t* SB = (bf16_t*)(ws + WS_S5B); bf16_t* SC = (bf16_t*)(ws + WS_S5C);
        for (int c = 0; c < 16; ++c) {
            const float br = a.in[10][gp * 16 + c], bi = a.in[11][gp * 16 + c];
            const float bbr = cre * br - cim * bi, bbi = cre * bi + cim * br;
            ((float*)(ws + WS_BRE))[gp * 16 + c] = bbr; ((float*)(ws + WS_BIM))[gp * 16 + c] = bbi;
            SB[(g * 128 + p) * 16 + c] = (bf16_t)f2bf(bbr); SB[(g * 128 + 64 + p) * 16 + c] = (bf16_t)f2bf(bbi);
            SC[(g * 16 + c) * 128 + p] = (bf16_t)f2bf(a.in[12][(g * 16 + c) * 64 + p]); SC[(g * 16 + c) * 128 + 64 + p] = (bf16_t)f2bf(-a.in[13][(g * 16 + c) * 64 + p]);
        }
    }
    rowpass(nullptr, nullptr, 0.f, a.in[0], nullptr, a.in[1], (bf16_t*)(ws + WS_H), gw, NGW, lane);
}

#ifndef MK_FAST_EVEN
#define MK_FAST_EVEN 1
#endif
#ifndef MK_FAST_ODD
#define MK_FAST_ODD 1
#endif
__device__ __forceinline__ f32x4 mfma16(bf16x8 a, bf16x8 b, f32x4 c) { return __builtin_amdgcn_mfma_f32_16x16x32_bf16(a, b, c, 0, 0, 0); }
__device__ __forceinline__ v2u pack4(f32x4 v) { v2u w; w.x = pk2(v[0], v[1]); w.y = pk2(v[2], v[3]); return w; }
#define BLK_SYNC() __syncthreads()
#define WAVE_LDS_FENCE() do { asm volatile("s_waitcnt lgkmcnt(0)" ::: "memory"); } while (0)

__device__ __forceinline__ void sgu_phase(const bf16_t* z, const float* ng, const bf16_t* wsgu, const float* bs, bf16_t* cat, LAS unsigned char* lds, int tid, int bid, int G) {
    LAS bf16_t* vnT = (LAS bf16_t*)lds;
    const int lane = tid & 63, w = __builtin_amdgcn_readfirstlane(tid >> 6), fr = lane & 15, fq = lane >> 4;
    for (int it = bid; it < 512; it += G) {
        const int h = it & 3, row0 = (it >> 2) * 128;
        {
            const int s = tid >> 2, q = tid & 3;
            const bf16_t* zr = z + (size_t)(row0 + s) * EVEN_IN + 1024 + q * 32;
            float keep[32]; float sum = 0.f, sq = 0.f;
#pragma unroll
            for (int hh = 0; hh < 4; ++hh) {
#pragma unroll
                for (int i = 0; i < 4; ++i) {
                    const v4u raw = *(const v4u*)(zr + hh * 128 + i * 8);
                    float v[8]; v[0] = gelu_t(bf2f(raw.x & 0xffffu)); v[1] = gelu_t(bf2f(raw.x >> 16)); v[2] = gelu_t(bf2f(raw.y & 0xffffu)); v[3] = gelu_t(bf2f(raw.y >> 16));
                    v[4] = gelu_t(bf2f(raw.z & 0xffffu)); v[5] = gelu_t(bf2f(raw.z >> 16)); v[6] = gelu_t(bf2f(raw.w & 0xffffu)); v[7] = gelu_t(bf2f(raw.w >> 16));
#pragma unroll
                    for (int e = 0; e < 8; ++e) { sum += v[e]; sq += v[e] * v[e]; if (hh == h) keep[i * 8 + e] = v[e]; }
                }
            }
            sum += __shfl_xor(sum, 1); sum += __shfl_xor(sum, 2); sq += __shfl_xor(sq, 1); sq += __shfl_xor(sq, 2);
            const float mu = sum * (1.f / 512.f), var = sq * (1.f / 512.f) - mu * mu, rs = 1.f / sqrtf(var + EPS);
#pragma unroll
            for (int i = 0; i < 32; ++i) { const int c = q * 32 + i; vnT[c * 136 + s] = (bf16_t)f2bf((keep[i] - mu) * rs * ng[h * 128 + c]); }
        }
        BLK_SYNC();
        f32x4 acc[8];
#pragma unroll
        for (int nt = 0; nt < 8; ++nt) acc[nt] = (f32x4){0.f, 0.f, 0.f, 0.f};
        const int nks = (w >> 1) + 1;
        for (int ks = 0; ks < nks; ++ks) {
            const bf16x8 af = *(const bf16x8*)(wsgu + (size_t)(h * 128 + 16 * w + fr) * 128 + ks * 32 + fq * 8);
#pragma unroll
            for (int nt = 0; nt < 8; ++nt) { const bf16x8 bfr = *(const LAS bf16x8*)(vnT + (16 * nt + fr) * 136 + ks * 32 + fq * 8); acc[nt] = mfma16(bfr, af, acc[nt]); }
        }
        {
            const int tt = 16 * w + fr; const size_t row = (size_t)(row0 + tt); const float bias = bs[h * 128 + tt];
#pragma unroll
            for (int nt = 0; nt < 8; ++nt) {
                const int c = 512 + h * 128 + 16 * nt + 4 * fq;
                const v2u ur = *(const v2u*)(z + row * EVEN_IN + c);
                f32x4 o; o[0] = gelu_t(bf2f(ur.x & 0xffffu)) * (acc[nt][0] + bias); o[1] = gelu_t(bf2f(ur.x >> 16)) * (acc[nt][1] + bias);
                o[2] = gelu_t(bf2f(ur.y & 0xffffu)) * (acc[nt][2] + bias); o[3] = gelu_t(bf2f(ur.y >> 16)) * (acc[nt][3] + bias);
                *(v2u*)(cat + row * D + c) = pack4(o);
            }
        }
        BLK_SYNC();
    }
}

template <int MODE>
__device__ __forceinline__ void s5_phase(const bf16_t* z, const float* are, const float* aim, const bf16_t* SB, const bf16_t* SC, const float* dsk, float* ends, bf16_t* yapre,
                                         LAS unsigned char* lds, int tid, int bid, int G) {
    const int lane = tid & 63, w = __builtin_amdgcn_readfirstlane(tid >> 6), fr = lane & 15, fq = lane >> 4;
    LAS float* BU = (LAS float*)(lds + w * 12800);
    LAS bf16_t* X = (LAS bf16_t*)(lds + w * 12800 + 8448);
    const bf16x8 zero8 = (bf16x8){0, 0, 0, 0, 0, 0, 0, 0};
    for (int it = bid * 8 + w; it < 8192; it += G * 8) {
        const int c64 = it & 63, g = (it >> 6) & 31, b = it >> 11;
        const float ar = are[g * 64 + lane], ai = aim[g * 64 + lane];
        bf16x8 bfr[8];
#pragma unroll
        for (int nt = 0; nt < 8; ++nt) bfr[nt] = fq < 2 ? *(const bf16x8*)(SB + (size_t)(g * 128 + 16 * nt + fr) * 16 + fq * 8) : zero8;
        float xr = 0.f, xi = 0.f;
        if (MODE == 1) {
            float pr = ar, pi = ai;
#pragma unroll
            for (int i = 0; i < 6; ++i) { const float nr = pr * pr - pi * pi, ni = 2.f * pr * pi; pr = nr; pi = ni; }
            const float* e = ends + (size_t)((b * 32 + g) * 64) * 128 + lane;
            for (int j = 0; j < c64; ++j) { const float er = e[j * 128], ei = e[j * 128 + 64]; const float nr = pr * xr - pi * xi + er, ni = pr * xi + pi * xr + ei; xr = nr; xi = ni; }
        }
        bf16x8 cfr[4];
        if (MODE == 1) {
#pragma unroll
            for (int ks = 0; ks < 4; ++ks) cfr[ks] = *(const bf16x8*)(SC + (size_t)(g * 16 + fr) * 128 + ks * 32 + fq * 8);
        }
        const size_t rowb = (size_t)b * SEQ + c64 * 64;
        for (int mt = 0; mt < 4; ++mt) {
            const bf16x8 af = fq < 2 ? *(const bf16x8*)(z + (rowb + mt * 16 + fr) * EVEN_IN + g * 16 + fq * 8) : zero8;
#pragma unroll
            for (int nt = 0; nt < 8; ++nt) {
                const f32x4 r = mfma16(af, bfr[nt], (f32x4){0.f, 0.f, 0.f, 0.f});
#pragma unroll
                for (int j = 0; j < 4; ++j) BU[(4 * fq + j) * 132 + 16 * nt + fr] = r[j];
            }
            WAVE_LDS_FENCE();
#pragma unroll
            for (int tt = 0; tt < 16; ++tt) {
                const float bur = BU[tt * 132 + lane], bui = BU[tt * 132 + 64 + lane];
                const float nr = ar * xr - ai * xi + bur, ni = ar * xi + ai * xr + bui; xr = nr; xi = ni;
                if (MODE == 1) { X[tt * 136 + lane] = (bf16_t)f2bf(xr); X[tt * 136 + 64 + lane] = (bf16_t)f2bf(xi); }
            }
            if (MODE == 1) {
                WAVE_LDS_FENCE();
                f32x4 y = (f32x4){0.f, 0.f, 0.f, 0.f};
#pragma unroll
                for (int ks = 0; ks < 4; ++ks) { const bf16x8 xa = *(const LAS bf16x8*)(X + fr * 136 + ks * 32 + fq * 8); y = mfma16(cfr[ks], xa, y); }
                const size_t row = rowb + mt * 16 + fr; const int c = g * 16 + 4 * fq;
                const v2u ur = *(const v2u*)(z + row * EVEN_IN + c); const f32x4 dv = *(const f32x4*)(dsk + c);
                f32x4 o; o[0] = gelu_t(y[0] + dv[0] * bf2f(ur.x & 0xffffu)); o[1] = gelu_t(y[1] + dv[1] * bf2f(ur.x >> 16));
                o[2] = gelu_t(y[2] + dv[2] * bf2f(ur.y & 0xffffu)); o[3] = gelu_t(y[3] + dv[3] * bf2f(ur.y >> 16));
                *(v2u*)(yapre + row * DH + c) = pack4(o);
            }
            WAVE_LDS_FENCE();
        }
        if (MODE == 0) { float* e = ends + (size_t)it * 128; e[lane] = xr; e[64 + lane] = xi; }
    }
}

__device__ __forceinline__ void pool_phase(const bf16_t* z, const bf16_t* wpool, const float* scale, bf16_t* cat, LAS unsigned char* lds, int tid, int bid, int G) {
    LAS bf16_t* At = (LAS bf16_t*)lds;
    const int lane = tid & 63, w = __builtin_amdgcn_readfirstlane(tid >> 6), fr = lane & 15, fq = lane >> 4;
    for (int it = bid; it < 512; it += G) {
        const int gi = it & 3, row0 = (it >> 2) * 128, win = 2 << gi;
        {
            const int t = tid >> 2, q = tid & 3, row = row0 + t, tpos = row & (SEQ - 1), cnt = (tpos + 1) < win ? (tpos + 1) : win;
            const bf16_t* zp = z + (size_t)row * ODD_IN + gi * 128 + q * 32;
            float s[32], x0[32];
#pragma unroll
            for (int i = 0; i < 32; ++i) s[i] = 0.f;
            for (int j = 0; j < cnt; ++j) {
#pragma unroll
                for (int i = 0; i < 4; ++i) {
                    const v4u raw = *(const v4u*)(zp - (size_t)j * ODD_IN + i * 8);
                    float v[8]; v[0] = bf2f(raw.x & 0xffffu); v[1] = bf2f(raw.x >> 16); v[2] = bf2f(raw.y & 0xffffu); v[3] = bf2f(raw.y >> 16);
                    v[4] = bf2f(raw.z & 0xffffu); v[5] = bf2f(raw.z >> 16); v[6] = bf2f(raw.w & 0xffffu); v[7] = bf2f(raw.w >> 16);
#pragma unroll
                    for (int e = 0; e < 8; ++e) { s[i * 8 + e] += v[e]; if (j == 0) x0[i * 8 + e] = v[e]; }
                }
            }
            const float inv = 1.f / (float)cnt;
#pragma unroll
            for (int i = 0; i < 4; ++i) {
                v4u o; o.x = pk2(s[i * 8 + 0] * inv - x0[i * 8 + 0], s[i * 8 + 1] * inv - x0[i * 8 + 1]); o.y = pk2(s[i * 8 + 2] * inv - x0[i * 8 + 2], s[i * 8 + 3] * inv - x0[i * 8 + 3]);
                o.z = pk2(s[i * 8 + 4] * inv - x0[i * 8 + 4], s[i * 8 + 5] * inv - x0[i * 8 + 5]); o.w = pk2(s[i * 8 + 6] * inv - x0[i * 8 + 6], s[i * 8 + 7] * inv - x0[i * 8 + 7]);
                *(LAS v4u*)(At + t * 136 + q * 32 + i * 8) = o;
            }
        }
        BLK_SYNC();
        f32x4 acc[8];
#pragma unroll
        for (int nt = 0; nt < 8; ++nt) acc[nt] = (f32x4){0.f, 0.f, 0.f, 0.f};
#pragma unroll
        for (int ks = 0; ks < 4; ++ks) {
            const bf16x8 af = *(const LAS bf16x8*)(At + (16 * w + fr) * 136 + ks * 32 + fq * 8);
#pragma unroll
            for (int nt = 0; nt < 8; ++nt) { const bf16x8 bfr = *(const bf16x8*)(wpool + (size_t)gi * 16384 + (16 * nt + fr) * 128 + ks * 32 + fq * 8); acc[nt] = mfma16(bfr, af, acc[nt]); }
        }
        {
            const size_t row = (size_t)(row0 + 16 * w + fr);
#pragma unroll
            for (int nt = 0; nt < 8; ++nt) { const int c = gi * 128 + 16 * nt + 4 * fq; const f32x4 sc = *(const f32x4*)(scale + c); *(v2u*)(cat + row * D + c) = pack4(acc[nt] * sc); }
        }
        BLK_SYNC();
    }
}

struct HgFront { float bcum[16]; float kk[16]; float blast; };
__device__ __forceinline__ void hg_front(HgFront& F, const bf16_t* z, size_t row0, int h, const float* lb_in, LAS float* part, int tid) {
    const int k = tid & 127, q = tid >> 7, d = h * 128 + k;
    const float lb = 1.f / (1.f + __expf(lb_in[d] - lb_in[512 + d]));
    float run = 0.f;
#pragma unroll
    for (int i = 0; i < 16; ++i) {
        const float zf = bf2f(z[(row0 + 16 * q + i) * ODD_IN + 1024 + d]);
        const float f = lb + (1.f - lb) * sigm_f(zf);
        run += __logf(f); F.bcum[i] = run; F.kk[i] = 1.f - f;
    }
    part[q * 128 + k] = run;
    BLK_SYNC();
    const float p0 = part[k], p1 = part[128 + k], p2 = part[256 + k], p3 = part[384 + k];
    const float off = (q > 0 ? p0 : 0.f) + (q > 1 ? p1 : 0.f) + (q > 2 ? p2 : 0.f);
    F.blast = (p0 + p1) + (p2 + p3);
#pragma unroll
    for (int i = 0; i < 16; ++i) F.bcum[i] += off;
}
__device__ __forceinline__ void hg_load_vT(const bf16_t* z, size_t row0, int h, LAS bf16_t* VT, int tid) {
    const int v = tid & 127, q = tid >> 7;
    float t16[16];
#pragma unroll
    for (int i = 0; i < 16; ++i) t16[i] = bf2f(z[(row0 + 16 * q + i) * ODD_IN + 1536 + h * 128 + v]);
    v4u o0, o1; o0.x = pk2(t16[0], t16[1]); o0.y = pk2(t16[2], t16[3]); o0.z = pk2(t16[4], t16[5]); o0.w = pk2(t16[6], t16[7]);
    o1.x = pk2(t16[8], t16[9]); o1.y = pk2(t16[10], t16[11]); o1.z = pk2(t16[12], t16[13]); o1.w = pk2(t16[14], t16[15]);
    *(LAS v4u*)(VT + v * 72 + 16 * q) = o0; *(LAS v4u*)(VT + v * 72 + 16 * q + 8) = o1;
}
__device__ __forceinline__ void hgrn_h1(const bf16_t* z, const float* lb_in, bf16_t* KV, float* DL, LAS unsigned char* lds, int tid, int bid, int G) {
    LAS bf16_t* KhT = (LAS bf16_t*)lds;
    LAS bf16_t* VT = (LAS bf16_t*)(lds + 18432);
    LAS float* part = (LAS float*)(lds + 36864);
    const int lane = tid & 63, w = __builtin_amdgcn_readfirstlane(tid >> 6), fr = lane & 15, fq = lane >> 4;
    for (int it = bid; it < 1024; it += G) {
        const int bh = it >> 6, c = it & 63, h = bh & 3; const size_t row0 = (size_t)(bh >> 2) * SEQ + c * 64;
        {
            HgFront F; hg_front(F, z, row0, h, lb_in, part, tid);
            const int k = tid & 127, q = tid >> 7;
            float kh[16];
#pragma unroll
            for (int i = 0; i < 16; ++i) kh[i] = F.kk[i] * __expf(F.blast - F.bcum[i]);
            v4u o0, o1; o0.x = pk2(kh[0], kh[1]); o0.y = pk2(kh[2], kh[3]); o0.z = pk2(kh[4], kh[5]); o0.w = pk2(kh[6], kh[7]);
            o1.x = pk2(kh[8], kh[9]); o1.y = pk2(kh[10], kh[11]); o1.z = pk2(kh[12], kh[13]); o1.w = pk2(kh[14], kh[15]);
            *(LAS v4u*)(KhT + k * 72 + 16 * q) = o0; *(LAS v4u*)(KhT + k * 72 + 16 * q + 8) = o1;
            if (q == 0) DL[(size_t)it * 128 + k] = __expf(F.blast);
            hg_load_vT(z, row0, h, VT, tid);
        }
        BLK_SYNC();
        f32x4 acc[8];
#pragma unroll
        for (int nt = 0; nt < 8; ++nt) acc[nt] = (f32x4){0.f, 0.f, 0.f, 0.f};
#pragma unroll
        for (int ks = 0; ks < 2; ++ks) {
            const bf16x8 af = *(const LAS bf16x8*)(VT + (16 * w + fr) * 72 + ks * 32 + fq * 8);
#pragma unroll
            for (int nt = 0; nt < 8; ++nt) { const bf16x8 bfr = *(const LAS bf16x8*)(KhT + (16 * nt + fr) * 72 + ks * 32 + fq * 8); acc[nt] = mfma16(bfr, af, acc[nt]); }
        }
        bf16_t* o = KV + (size_t)it * 16384 + (size_t)(16 * w + fr) * 128;
#pragma unroll
        for (int nt = 0; nt < 8; ++nt) *(v2u*)(o + 16 * nt + 4 * fq) = pack4(acc[nt]);
        BLK_SYNC();
    }
}
__device__ __forceinline__ void hgrn_h2(bf16_t* KV, const float* DL, int tid, int bid, int G) {
    for (int gt = bid * 512 + tid; gt < 131072; gt += G * 512) {
        const int bh = gt >> 13, rem = gt & 8191, v = rem >> 6, kp = rem & 63;
        unsigned* p = (unsigned*)(KV + (size_t)bh * 64 * 16384 + (size_t)v * 128 + 2 * kp);
        const float* dl = DL + (size_t)bh * 64 * 128 + 2 * kp;
        float s0 = 0.f, s1 = 0.f;
#pragma unroll 8
        for (int c = 0; c < 64; ++c) {
            const unsigned kv = p[(size_t)c * 8192]; const float d0 = dl[c * 128], d1 = dl[c * 128 + 1];
            p[(size_t)c * 8192] = pk2(s0, s1);
            s0 = d0 * s0 + bf2f(kv & 0xffffu); s1 = d1 * s1 + bf2f(kv >> 16);
        }
    }
}
__device__ __forceinline__ void hgrn_h3(const bf16_t* z, const float* lb_in, const float* onorm, const bf16_t* KV, bf16_t* cat, LAS unsigned char* lds, int tid, int bid, int G) {
    LAS bf16_t* Qt = (LAS bf16_t*)lds;
    LAS bf16_t* Kt = (LAS bf16_t*)(lds + 17408);
    LAS bf16_t* VT = (LAS bf16_t*)(lds + 34816);
    LAS bf16_t* P = (LAS bf16_t*)(lds + 53248);
    LAS float* O = (LAS float*)(lds + 62464);
    LAS float* part = (LAS float*)(lds + 96256);
    const int lane = tid & 63, w = __builtin_amdgcn_readfirstlane(tid >> 6), fr = lane & 15, fq = lane >> 4;
    for (int it = bid; it < 1024; it += G) {
        const int bh = it >> 6, c = it & 63, h = bh & 3; const size_t row0 = (size_t)(bh >> 2) * SEQ + c * 64;
        {
            HgFront F; hg_front(F, z, row0, h, lb_in, part, tid);
            const int k = tid & 127, q = tid >> 7;
#pragma unroll
            for (int i = 0; i < 16; ++i) {
                const float bc = fmaxf(F.bcum[i], -80.f);
                const float zq = bf2f(z[(row0 + 16 * q + i) * ODD_IN + 512 + h * 128 + k]);
                Qt[(16 * q + i) * 136 + k] = (bf16_t)f2bf(silu_f(zq) * __expf(bc));
                Kt[(16 * q + i) * 136 + k] = (bf16_t)f2bf(F.kk[i] * __expf(-bc));
            }
            hg_load_vT(z, row0, h, VT, tid);
        }
        BLK_SYNC();
        {
            const int mt = w & 3;
#pragma unroll
            for (int u = 0; u < 2; ++u) {
                const int nt = 2 * (w >> 2) + u;
                f32x4 s = (f32x4){0.f, 0.f, 0.f, 0.f};
                if (nt <= mt) {
#pragma unroll
                    for (int ks = 0; ks < 4; ++ks) {
                        const bf16x8 af = *(const LAS bf16x8*)(Qt + (16 * mt + fr) * 136 + ks * 32 + fq * 8);
                        const bf16x8 bfr = *(const LAS bf16x8*)(Kt + (16 * nt + fr) * 136 + ks * 32 + fq * 8);
                        s = mfma16(bfr, af, s);
                    }
                    const int t = 16 * mt + fr, s0 = 16 * nt + 4 * fq;
#pragma unroll
                    for (int j = 0; j < 4; ++j) if (s0 + j > t) s[j] = 0.f;
                }
                *(LAS v2u*)(P + (16 * mt + fr) * 72 + 16 * nt + 4 * fq) = pack4(s);
            }
        }
        BLK_SYNC();
        {
            const int mt = w & 3, nt0 = 4 * (w >> 2);
            f32x4 acc[4];
#pragma unroll
            for (int u = 0; u < 4; ++u) acc[u] = (f32x4){0.f, 0.f, 0.f, 0.f};
#pragma unroll
            for (int ks = 0; ks < 2; ++ks) {
                const bf16x8 af = *(const LAS bf16x8*)(P + (16 * mt + fr) * 72 + ks * 32 + fq * 8);
#pragma unroll
                for (int u = 0; u < 4; ++u) { const bf16x8 bfr = *(const LAS bf16x8*)(VT + (16 * (nt0 + u) + fr) * 72 + ks * 32 + fq * 8); acc[u] = mfma16(bfr, af, acc[u]); }
            }
            const bf16_t* st = KV + (size_t)it * 16384;
#pragma unroll
            for (int ks = 0; ks < 4; ++ks) {
                const bf16x8 af = *(const LAS bf16x8*)(Qt + (16 * mt + fr) * 136 + ks * 32 + fq * 8);
#pragma unroll
                for (int u = 0; u < 4; ++u) { const bf16x8 bfr = *(const bf16x8*)(st + (size_t)(16 * (nt0 + u) + fr) * 128 + ks * 32 + fq * 8); acc[u] = mfma16(bfr, af, acc[u]); }
            }
#pragma unroll
            for (int u = 0; u < 4; ++u) *(LAS f32x4*)(O + (16 * mt + fr) * 132 + 16 * (nt0 + u) + 4 * fq) = acc[u];
        }
        BLK_SYNC();
        {
            const int t = tid >> 3, pt = tid & 7;
            f32x4 o[4]; float ss = 0.f;
#pragma unroll
            for (int i = 0; i < 4; ++i) { o[i] = *(const LAS f32x4*)(O + t * 132 + 16 * pt + 4 * i); ss += (o[i][0] * o[i][0] + o[i][1] * o[i][1]) + (o[i][2] * o[i][2] + o[i][3] * o[i][3]); }
            ss += __shfl_xor(ss, 1); ss += __shfl_xor(ss, 2); ss += __shfl_xor(ss, 4);
            const float r = 1.f / sqrtf(ss * (1.f / 128.f) + EPS);
            const size_t row = row0 + t; const int cb = h * 128 + 16 * pt;
            const v4u g0 = *(const v4u*)(z + row * ODD_IN + 2048 + cb), g1 = *(const v4u*)(z + row * ODD_IN + 2048 + cb + 8);
            float zg[16]; zg[0] = bf2f(g0.x & 0xffffu); zg[1] = bf2f(g0.x >> 16); zg[2] = bf2f(g0.y & 0xffffu); zg[3] = bf2f(g0.y >> 16); zg[4] = bf2f(g0.z & 0xffffu); zg[5] = bf2f(g0.z >> 16); zg[6] = bf2f(g0.w & 0xffffu); zg[7] = bf2f(g0.w >> 16);
            zg[8] = bf2f(g1.x & 0xffffu); zg[9] = bf2f(g1.x >> 16); zg[10] = bf2f(g1.y & 0xffffu); zg[11] = bf2f(g1.y >> 16); zg[12] = bf2f(g1.z & 0xffffu); zg[13] = bf2f(g1.z >> 16); zg[14] = bf2f(g1.w & 0xffffu); zg[15] = bf2f(g1.w >> 16);
            float res[16];
#pragma unroll
            for (int i = 0; i < 4; ++i) { const f32x4 og = *(const f32x4*)(onorm + 16 * pt + 4 * i);
#pragma unroll
                for (int j = 0; j < 4; ++j) res[4 * i + j] = o[i][j] * r * og[j] * silu_f(zg[4 * i + j]); }
            v4u w0, w1; w0.x = pk2(res[0], res[1]); w0.y = pk2(res[2], res[3]); w0.z = pk2(res[4], res[5]); w0.w = pk2(res[6], res[7]);
            w1.x = pk2(res[8], res[9]); w1.y = pk2(res[10], res[11]); w1.z = pk2(res[12], res[13]); w1.w = pk2(res[14], res[15]);
            *(v4u*)(cat + row * D + 512 + cb) = w0; *(v4u*)(cat + row * D + 512 + cb + 8) = w1;
        }
        BLK_SYNC();
    }
}

#define MIX_PHASE_A { FRESH(); if (li == 0) { \
        sgu_phase(WSP(const bf16_t, WS_Z), ka->in[16], WSP(const bf16_t, WS_WSGU), ka->in[18], WSP(bf16_t, WS_CAT), lds, tid, bid, G); \
        s5_phase<0>(WSP(const bf16_t, WS_Z), WSP(const float, WS_ARE), WSP(const float, WS_AIM), WSP(const bf16_t, WS_S5B), WSP(const bf16_t, WS_S5C), ka->in[14], WSP(float, WS_KV), WSP(bf16_t, WS_YAPRE), lds, tid, bid, G); \
    } else { \
        pool_phase(WSP(const bf16_t, WS_Z), WSP(const bf16_t, WS_WPOOL), ka->in[22], WSP(bf16_t, WS_CAT), lds, tid, bid, G); \
        hgrn_h1(WSP(const bf16_t, WS_Z), ka->in[23], WSP(bf16_t, WS_KV), WSP(float, WS_DL), lds, tid, bid, G); } }
#define MIX_PHASE_B { FRESH(); if (li == 0) { \
        s5_phase<1>(WSP(const bf16_t, WS_Z), WSP(const float, WS_ARE), WSP(const float, WS_AIM), WSP(const bf16_t, WS_S5B), WSP(const bf16_t, WS_S5C), ka->in[14], WSP(float, WS_KV), WSP(bf16_t, WS_YAPRE), lds, tid, bid, G); \
    } else { hgrn_h2(WSP(bf16_t, WS_KV), WSP(const float, WS_DL), tid, bid, G); } }
#define MIX_PHASE_C { FRESH(); hgrn_h3(WSP(const bf16_t, WS_Z), ka->in[23], ka->in[24], WSP(const bf16_t, WS_KV), WSP(bf16_t, WS_CAT), lds, tid, bid, G); }

__global__ void __launch_bounds__(256) sgu_stats_naive(const bf16_t* z, float* stats) {
    const int row = blockIdx.x * 4 + (threadIdx.x >> 6), lane = threadIdx.x & 63;
    const v4u raw = *(const v4u*)(z + (size_t)row * EVEN_IN + 1024 + lane * 8);
    float v[8]; v[0] = gelu_t(bf2f(raw.x & 0xffffu)); v[1] = gelu_t(bf2f(raw.x >> 16)); v[2] = gelu_t(bf2f(raw.y & 0xffffu)); v[3] = gelu_t(bf2f(raw.y >> 16));
    v[4] = gelu_t(bf2f(raw.z & 0xffffu)); v[5] = gelu_t(bf2f(raw.z >> 16)); v[6] = gelu_t(bf2f(raw.w & 0xffffu)); v[7] = gelu_t(bf2f(raw.w >> 16));
    float s = 0.f; for (int i = 0; i < 8; ++i) s += v[i];
    const float mean = wave_sum(s) * (1.f / 512.f); float q = 0.f; for (int i = 0; i < 8; ++i) q += (v[i] - mean) * (v[i] - mean);
    const float var = wave_sum(q) * (1.f / 512.f);
    if (lane == 0) { stats[row * 2] = mean; stats[row * 2 + 1] = 1.f / sqrtf(var + EPS); }
}
__global__ void __launch_bounds__(256) sgu_naive(const bf16_t* z, const float* stats, const float* ng, const float* w, const float* bs, bf16_t* cat) {
    const int idx = blockIdx.x * 256 + threadIdx.x, row = idx >> 9, c = idx & 511, h = c >> 7, tt = row & 127, row0 = row - tt;
    float acc = bs[h * 128 + tt]; const float g = ng[c];
    for (int s = 0; s <= tt; ++s) { const int r = row0 + s; const float vn = (gelu_t(bf2f(z[(size_t)r * EVEN_IN + 1024 + c])) - stats[2 * r]) * stats[2 * r + 1] * g; acc += w[(h * 128 + tt) * 128 + s] * vn; }
    const float u = gelu_t(bf2f(z[(size_t)row * EVEN_IN + 512 + c]));
    cat[(size_t)row * D + 512 + c] = (bf16_t)f2bf(u * acc);
}
__global__ void __launch_bounds__(64) s5_naive(const bf16_t* z, const float* are, const float* aim, const float* bre, const float* bim, const float* cre_in, const float* cim_in, const float* dsk, bf16_t* yapre) {
    const int b = blockIdx.x >> 5, g = blockIdx.x & 31, lane = threadIdx.x, gp = g * 64 + lane;
    float Br[16], Bi[16], Cr[16], Ci[16];
#pragma unroll
    for (int c = 0; c < 16; ++c) { Br[c] = bre[gp * 16 + c]; Bi[c] = bim[gp * 16 + c]; Cr[c] = cre_in[(g * 16 + c) * 64 + lane]; Ci[c] = cim_in[(g * 16 + c) * 64 + lane]; }
    const float ar = are[gp], ai = aim[gp], dv = dsk[g * 16 + (lane & 15)];
    float xr = 0.f, xi = 0.f;
    for (int t = 0; t < SEQ; ++t) {
        const size_t row = (size_t)b * SEQ + t;
        const v4u u0 = *(const v4u*)(z + row * EVEN_IN + g * 16), u1 = *(const v4u*)(z + row * EVEN_IN + g * 16 + 8);
        float u[16];
        u[0] = bf2f(u0.x & 0xffffu); u[1] = bf2f(u0.x >> 16); u[2] = bf2f(u0.y & 0xffffu); u[3] = bf2f(u0.y >> 16); u[4] = bf2f(u0.z & 0xffffu); u[5] = bf2f(u0.z >> 16); u[6] = bf2f(u0.w & 0xffffu); u[7] = bf2f(u0.w >> 16);
        u[8] = bf2f(u1.x & 0xffffu); u[9] = bf2f(u1.x >> 16); u[10] = bf2f(u1.y & 0xffffu); u[11] = bf2f(u1.y >> 16); u[12] = bf2f(u1.z & 0xffffu); u[13] = bf2f(u1.z >> 16); u[14] = bf2f(u1.w & 0xffffu); u[15] = bf2f(u1.w >> 16);
        float bur = 0.f, bui = 0.f;
#pragma unroll
        for (int c = 0; c < 16; ++c) { bur += u[c] * Br[c]; bui += u[c] * Bi[c]; }
        const float nr = ar * xr - ai * xi + bur, ni = ar * xi + ai * xr + bui; xr = nr; xi = ni;
        float myy = 0.f, myu = 0.f;
#pragma unroll
        for (int c = 0; c < 16; ++c) { const float s = wave_sum(xr * Cr[c] - xi * Ci[c]); if (lane == c) { myy = s; myu = u[c]; } }
        if (lane < 16) yapre[row * DH + g * 16 + lane] = (bf16_t)f2bf(gelu_t(myy + dv * myu));
    }
}
__global__ void __launch_bounds__(256) pool_prep_naive(const bf16_t* z, float* A) {
    const int idx = blockIdx.x * 256 + threadIdx.x, row = idx >> 9, c = idx & 511, gi = c >> 7, win = 2 << gi, t = row & (SEQ - 1), cnt = (t + 1) < win ? (t + 1) : win;
    float s = 0.f; for (int j = 0; j < cnt; ++j) s += bf2f(z[(size_t)(row - j) * ODD_IN + c]);
    A[idx] = s / (float)cnt - bf2f(z[(size_t)row * ODD_IN + c]);
}
__global__ void __launch_bounds__(256) pool_naive(const float* A, const float* pw, const float* scale, bf16_t* cat) {
    const int idx = blockIdx.x * 256 + threadIdx.x, row = idx >> 9, c = idx & 511, gi = c >> 7, n = c & 127;
    float acc = 0.f; for (int k = 0; k < 128; ++k) acc += A[(size_t)row * DH + gi * 128 + k] * pw[(gi * 128 + k) * 128 + n];
    cat[(size_t)row * D + c] = (bf16_t)f2bf(acc * scale[c]);
}
__global__ void __launch_bounds__(128) hgrn_naive(const bf16_t* z, const float* lb_in, const float* onorm, bf16_t* cat) {
    __shared__ float qs[128], fs[128], ks[128], red[2];
    const int b = blockIdx.x >> 2, h = blockIdx.x & 3, v = threadIdx.x, d = h * 128 + v, lane = v & 63, wv = v >> 6;
    const float lb = 1.f / (1.f + expf(lb_in[d] - lb_in[512 + d])), og = onorm[v];
    float S[128];
#pragma unroll
    for (int k = 0; k < 128; ++k) S[k] = 0.f;
    for (int t = 0; t < SEQ; ++t) {
        const size_t row = (size_t)b * SEQ + t; const bf16_t* zr = z + row * ODD_IN;
        const float zq = bf2f(zr[512 + d]), zf = bf2f(zr[1024 + d]), zi = bf2f(zr[1536 + d]), zg = bf2f(zr[2048 + d]);
        const float f = lb + (1.f - lb) * sigm_f(zf);
        qs[v] = silu_f(zq); fs[v] = f; ks[v] = 1.f - f;
        __syncthreads();
        float o = 0.f;
#pragma unroll
        for (int k = 0; k < 128; ++k) { S[k] = fs[k] * S[k] + ks[k] * zi; o += qs[k] * S[k]; }
        const float ss = wave_sum(o * o); if (lane == 0) red[wv] = ss;
        __syncthreads();
        const float tot = red[0] + red[1];
        cat[row * D + 512 + d] = (bf16_t)f2bf(o / sqrtf(tot * (1.f / 128.f) + EPS) * og * silu_f(zg));
    }
}

constexpr int N_PHASES = 25;
typedef const __attribute__((address_space(4))) Args* KArgs;
#define FRESH() \
    KArgs ka = (KArgs)__builtin_amdgcn_kernarg_segment_ptr(); asm volatile("" : "+s"(ka)); \
    int tid = threadIdx.x; asm volatile("" : "+v"(tid)); \
    int bid = blockIdx.x; asm volatile("" : "+s"(bid)); \
    int G = gridDim.x; asm volatile("" : "+s"(G)); \
    const int lane = tid & 63, wave = __builtin_amdgcn_readfirstlane(tid >> 6), gw = bid * 8 + wave, NGW = G * 8; \
    unsigned char* ws = ka->ws; (void)lane; (void)gw; (void)NGW; (void)ws
#define WSP(T, off) ((T*)(ws + (off)))

__global__ void __launch_bounds__(512, 2) mega(Args a) {
    extern __shared__ __attribute__((aligned(16))) unsigned char lds_raw[];
    LAS unsigned char* lds = (LAS unsigned char*)lds_raw;
    const int ph_lo = a.ph_lo, ph_hi = a.ph_hi;
    for (int ph = ph_lo; ph < ph_hi; ++ph) {
        if (ph > ph_lo) cg::this_grid().sync();
        if (ph == 0) { FRESH(); Args al; for (int i = 0; i < 25; ++i) al.in[i] = ka->in[i]; al.out = ka->out; al.ws = ka->ws; prologue(al, lds, gw, NGW, wave, lane); continue; }
        const int li = (ph - 1) / 12, k = (ph - 1) % 12;
        switch (k) {
        case 0: case 9: {
            FRESH();
            pg8::Gemm g{WSP(bf16_t, WS_H), WSP(const bf16_t, WS_WGU), M, 2 * DFF, D}; pg8::StaticOrder S; S.init(M, 2 * DFF, G, bid);
            EpiSwiGLU E{WSP(bf16_t, WS_HID)};
            pg8::gemm_phase<EpiSwiGLU, pg8::StaticOrder, PG8_ALIGN, PG8_SP2>(lds, g, S, E, tid);
        } break;
        case 1: case 10: {
            FRESH();
            pg8::Gemm g{WSP(bf16_t, WS_HID), WSP(const bf16_t, WS_WD), M, D, DFF}; pg8::StaticOrder S; S.init(M, D, G, bid);
            EpiF32 E{WSP(float, WS_YFFN), D};
            pg8::gemm_phase<EpiF32, pg8::StaticOrder, PG8_ALIGN, PG8_SP2>(lds, g, S, E, tid);
        } break;
        case 2: { FRESH(); const float* ng = ka->in[1] + (size_t)li * 6 * D;
            rowpass(WSP(float, WS_YFFN), ng + 1 * D, 0.5f, (ph == 3) ? ka->in[0] : ka->out, ka->out, ng + 2 * D, WSP(bf16_t, WS_H), gw, NGW, lane); } break;
        case 3: {
            FRESH();
            const int N = li == 0 ? EVEN_IN : ODD_IN;
            pg8::Gemm g{WSP(bf16_t, WS_H), (const bf16_t*)(ws + (li == 0 ? WS_WEIN : WS_WOIN)), M, N, D}; pg8::StaticOrder S; S.init(M, N, G, bid);
            EpiBf E{WSP(bf16_t, WS_Z), N};
            pg8::gemm_phase<EpiBf, pg8::StaticOrder, PG8_ALIGN, PG8_SP2>(lds, g, S, E, tid);
        } break;
        case 4: { MIX_PHASE_A } break;
        case 5: { MIX_PHASE_B } break;
        case 6: {
            if (li == 0) {
                FRESH();
                pg8::Gemm g{WSP(bf16_t, WS_YAPRE), WSP(const bf16_t, WS_WGLU), M, DH, DH}; pg8::StaticOrder S; S.init(M, DH, G, bid);
                EpiGLU E{WSP(const bf16_t, WS_YAPRE), WSP(bf16_t, WS_CAT)};
                pg8::gemm_phase<EpiGLU, pg8::StaticOrder, PG8_ALIGN, PG8_SP2>(lds, g, S, E, tid);
            } else { MIX_PHASE_C }
        } break;
        case 7: {
            FRESH();
            pg8::Gemm g{WSP(bf16_t, WS_CAT), (const bf16_t*)(ws + (li == 0 ? WS_WEOUT : WS_WOOUT)), M, D, D}; pg8::StaticOrder S; S.init(M, D, G, bid);
            EpiF32 E{WSP(float, WS_YMIX), D};
            pg8::gemm_phase<EpiF32, pg8::StaticOrder, PG8_ALIGN, PG8_SP2>(lds, g, S, E, tid);
        } break;
        case 8: {
            FRESH(); const float* ng = ka->in[1] + (size_t)li * 6 * D;
            rowpass(WSP(float, WS_YMIX), ng + 3 * D, 1.0f, ka->out, ka->out, ng + 4 * D, WSP(bf16_t, WS_H), gw, NGW, lane);
            const size_t o = (size_t)(li * 2 + 1) * D * DFF;
            convert_ffn(ka->in[2] + o, ka->in[3] + o, ka->in[4] + o, ws, (LAS float*)(lds + wave * 16384), gw, NGW, lane);
        } break;
        case 11: {
            FRESH(); const float* ng = ka->in[1] + (size_t)li * 6 * D;
            rowpass(WSP(float, WS_YFFN), ng + 5 * D, 0.5f, ka->out, ka->out, li < 1 ? ka->in[1] + (size_t)(li + 1) * 6 * D : nullptr, WSP(bf16_t, WS_H), gw, NGW, lane);
            if (li < 1) { const size_t o = (size_t)((li + 1) * 2) * D * DFF;
                convert_ffn(ka->in[2] + o, ka->in[3] + o, ka->in[4] + o, ws, (LAS float*)(lds + wave * 16384), gw, NGW, lane); }
        } break;
        default: break;
        }
    }
}

#ifndef MK_ONE_LAUNCH
#define MK_ONE_LAUNCH 1
#endif
extern "C" void kernel_launch(void* const* d_in, const int* in_sizes, int n_in, void* d_out, int out_size, void* d_ws, size_t ws_size, hipStream_t stream) {
    static int grid = 0;
    if (grid == 0) {
        if (hipFuncSetAttribute((const void*)mega, hipFuncAttributeMaxDynamicSharedMemorySize, LDS_BYTES) != hipSuccess) { fprintf(stderr, "kernel_launch: hipFuncSetAttribute failed\n"); grid = -1; return; }
        int dev = 0, cus = 0, per_cu = 0;
        (void)hipGetDevice(&dev); (void)hipDeviceGetAttribute(&cus, hipDeviceAttributeMultiprocessorCount, dev);
        (void)hipOccupancyMaxActiveBlocksPerMultiprocessor(&per_cu, (const void*)mega, 512, LDS_BYTES);
        if (per_cu < 1) per_cu = 1;
        if (cus < 1) cus = 256;
        grid = cus * per_cu;
        (void)hipGetLastError();
    }
    if (grid < 0) return;
    Args a{};
    for (int i = 0; i < 25; ++i) a.in[i] = (const float*)d_in[i];
    a.out = (float*)d_out; a.ws = (unsigned char*)d_ws;
    unsigned char* ws = (unsigned char*)d_ws;
#if MK_ONE_LAUNCH
    a.ph_lo = 0; a.ph_hi = N_PHASES;
    void* args[] = {&a};
    hipError_t e = hipLaunchCooperativeKernel((const void*)mega, dim3(grid), dim3(512), args, LDS_BYTES, stream);
    if (e != hipSuccess) fprintf(stderr, "cooperative launch failed: %s (grid %d)\n", hipGetErrorString(e), grid);
#else
    auto run = [&](int lo, int hi) { a.ph_lo = lo; a.ph_hi = hi; hipLaunchKernelGGL(mega, dim3(grid), dim3(512), LDS_BYTES, stream, a); };
    const bf16_t* Zp = (const bf16_t*)(ws + WS_Z); bf16_t* CATp = (bf16_t*)(ws + WS_CAT);
    for (int ph = 0; ph < N_PHASES; ++ph) {
        const int li = ph == 0 ? 0 : (ph - 1) / 12, k = ph == 0 ? -1 : (ph - 1) % 12;
#if !MK_FAST_EVEN
        if (k == 4 && li == 0) {
            sgu_stats_naive<<<M / 4, 256, 0, stream>>>(Zp, (float*)(ws + WS_STATS));
            sgu_naive<<<M * 512 / 256, 256, 0, stream>>>(Zp, (const float*)(ws + WS_STATS), a.in[16], a.in[17], a.in[18], CATp);
            s5_naive<<<128, 64, 0, stream>>>(Zp, (const float*)(ws + WS_ARE), (const float*)(ws + WS_AIM), (const float*)(ws + WS_BRE), (const float*)(ws + WS_BIM), a.in[12], a.in[13], a.in[14], (bf16_t*)(ws + WS_YAPRE));
            continue;
        }
        if (k == 5 && li == 0) continue;
#endif
#if !MK_FAST_ODD
        if (k == 4 && li == 1) {
            pool_prep_naive<<<M * 512 / 256, 256, 0, stream>>>(Zp, (float*)(ws + WS_POOLA));
            pool_naive<<<M * 512 / 256, 256, 0, stream>>>((const float*)(ws + WS_POOLA), a.in[21], a.in[22], CATp);
            hgrn_naive<<<16, 128, 0, stream>>>(Zp, a.in[23], a.in[24], CATp);
            continue;
        }
        if ((k == 5 || k == 6) && li == 1) continue;
#endif
        run(ph, ph + 1);
    }
#endif
}
```
